# Optimizing an MI355X kernel written in HIP

```python
import math
import jax, jax.numpy as jnp
from jax import lax
import numpy as np

D_MODEL = 2048
BATCH = 1
SEQ = 16384
DEPTH = 2

CHUNK = 64
N_MIXERS = 2
N_A_LAYERS = (DEPTH + 1) // 2
N_B_LAYERS = DEPTH // 2
D_RNN = 2560
LRU_HEADS = 16
LRU_HEAD_DIM = D_RNN // LRU_HEADS
CONV_WIDTH = 4
LRU_C = 8.0
D_SSM = 1024
SSM_GROUP = 16
SSM_GROUPS = D_SSM // SSM_GROUP
SSM_STATE = 64
DT_MIN = 1e-3
DT_MAX = 1e-1
N_GROUPS = 4
EXPERTS_PER_GROUP = 8
N_EXPERTS = N_GROUPS * EXPERTS_PER_GROUP
TOP_K = 2
D_EXPERT = 512
MOE_BLOCK = 128
EPS = 1e-6

kernel_name = "hybrid_rglru_s5_hmoe_encoder"


def rms_norm(x, g):
    x32 = x.astype(jnp.float32)
    y = x32 * lax.rsqrt(jnp.mean(x32 * x32, axis=-1, keepdims=True) + EPS) * g.astype(jnp.float32)
    return y.astype(x.dtype)


def real_combine(e1, e2):
    a1, b1 = e1
    a2, b2 = e2
    return a1 * a2, a2 * b1 + b2


def cplx_combine(e1, e2):
    a1r, a1i, b1r, b1i = e1
    a2r, a2i, b2r, b2i = e2
    ar = a2r * a1r - a2i * a1i
    ai = a2r * a1i + a2i * a1r
    br = a2r * b1r - a2i * b1i + b2r
    bi = a2r * b1i + a2i * b1r + b2i
    return ar, ai, br, bi


def rglru_block(x, w_in, conv_w, conv_b, wa, ba, wx, bx, lru_L, w_out):
    b, s, _ = x.shape
    gate_br, rec = jnp.split(x @ w_in, 2, axis=-1)
    rec_pad = jnp.pad(rec, ((0, 0), (CONV_WIDTH - 1, 0), (0, 0)))
    conv = conv_b
    for k in range(CONV_WIDTH):
        conv = conv + rec_pad[:, k:k + s] * conv_w[k]
    xh = conv.reshape(b, s, LRU_HEADS, LRU_HEAD_DIM)
    r = jax.nn.sigmoid(jnp.einsum('bshi,hij->bshj', xh, wa) + ba).reshape(b, s, D_RNN)
    i = jax.nn.sigmoid(jnp.einsum('bshi,hij->bshj', xh, wx) + bx).reshape(b, s, D_RNN)
    log_a = (-LRU_C * r.astype(jnp.float32)) * jax.nn.softplus(-lru_L.astype(jnp.float32))
    a = jnp.exp(log_a)
    bt = jnp.sqrt(-jnp.expm1(2.0 * log_a)) * (i * conv).astype(jnp.float32)
    _, h = lax.associative_scan(real_combine, (a, bt), axis=1)
    y = h.astype(x.dtype) * jax.nn.gelu(gate_br)
    return y @ w_out


def s5_block(x, w_in, lam_re, lam_im, log_dt, b_re, b_im, c_re, c_im, d_skip, w_glu):
    b, s, _ = x.shape
    nc = s // CHUNK
    f32 = jnp.float32
    u = (x @ w_in).astype(f32)
    lre = jnp.minimum(lam_re.astype(f32), -1e-4)
    lim = lam_im.astype(f32)
    dt = jnp.exp(log_dt.astype(f32))[:, None]
    mag = jnp.exp(lre * dt)
    abr = mag * jnp.cos(lim * dt)
    abi = mag * jnp.sin(lim * dt)
    den = lre * lre + lim * lim
    kr = ((abr - 1.0) * lre + abi * lim) / den
    ki = (abi * lre - (abr - 1.0) * lim) / den
    br, bi = b_re.astype(f32), b_im.astype(f32)
    bbar_r = kr[..., None] * br - ki[..., None] * bi
    bbar_i = kr[..., None] * bi + ki[..., None] * br
    ug = u.reshape(b, nc, CHUNK, SSM_GROUPS, SSM_GROUP)
    bur = jnp.einsum('bncgk,gpk->bncgp', ug, bbar_r)
    bui = jnp.einsum('bncgk,gpk->bncgp', ug, bbar_i)
    shp = bur.shape
    elems = (jnp.broadcast_to(abr, shp), jnp.broadcast_to(abi, shp), bur, bui)
    pr, pi, loc_r, loc_i = lax.associative_scan(cplx_combine, elems, axis=2)
    summary = (pr[:, :, -1], pi[:, :, -1], loc_r[:, :, -1], loc_i[:, :, -1])
    _, _, sr, si = lax.associative_scan(cplx_combine, summary, axis=1)
    pad = ((0, 0), (1, 0), (0, 0), (0, 0))
    prev_r = jnp.pad(sr[:, :-1], pad)[:, :, None]
    prev_i = jnp.pad(si[:, :-1], pad)[:, :, None]
    xr = loc_r + pr * prev_r - pi * prev_i
    xi = loc_i + pr * prev_i + pi * prev_r
    y = jnp.einsum('bncgp,gkp->bncgk', xr, c_re) - jnp.einsum('bncgp,gkp->bncgk', xi, c_im)
    y = y.reshape(b, s, D_SSM) + d_skip * u
    z = jax.nn.gelu(y).astype(x.dtype)
    v, g = jnp.split(z @ w_glu, 2, axis=-1)
    return v * jax.nn.sigmoid(g)


def hier_moe(x, wg, bg, we, be, w1, w3, w2):
    b, s, d = x.shape
    n_tok = b * s
    xt = x.reshape(n_tok, d)
    g_logits = (xt @ wg).astype(jnp.float32) + bg
    g_prob = jax.nn.softmax(g_logits, axis=-1)
    g_idx = jnp.argmax(g_logits, axis=-1).astype(jnp.int32)
    p_group = jnp.take_along_axis(g_prob, g_idx[:, None], axis=1)
    e_logits = jnp.einsum('td,gde->tge', xt, we).astype(jnp.float32) + be
    e_logits = jnp.take_along_axis(e_logits, g_idx[:, None, None], axis=1)[:, 0]
    top_v, top_i = lax.top_k(e_logits, TOP_K)
    gate = jax.nn.softmax(top_v, axis=-1) * p_group
    e_idx = g_idx[:, None] * EXPERTS_PER_GROUP + top_i.astype(jnp.int32)
    n_assign = n_tok * TOP_K
    n_blocks = (n_assign + N_EXPERTS * (MOE_BLOCK - 1) + MOE_BLOCK - 1) // MOE_BLOCK
    flat_e = e_idx.reshape(-1)
    flat_t = jnp.repeat(jnp.arange(n_tok, dtype=jnp.int32), TOP_K)
    flat_w = gate.reshape(-1)
    order = jnp.argsort(flat_e)
    se, st, sw = flat_e[order], flat_t[order], flat_w[order]
    counts = jnp.bincount(flat_e, length=N_EXPERTS).astype(jnp.int32)
    starts = jnp.cumsum(counts) - counts
    pcounts = (counts + MOE_BLOCK - 1) // MOE_BLOCK * MOE_BLOCK
    pends = jnp.cumsum(pcounts)
    pstarts = pends - pcounts
    dest = pstarts[se] + jnp.arange(n_assign, dtype=jnp.int32) - starts[se]
    n_rows = n_blocks * MOE_BLOCK
    buf_t = jnp.zeros((n_rows,), jnp.int32).at[dest].set(st)
    buf_w = jnp.zeros((n_rows,), jnp.float32).at[dest].set(sw)
    blk_e = jnp.minimum(jnp.searchsorted(pends, jnp.arange(n_blocks, dtype=jnp.int32) * MOE_BLOCK, side='right'), N_EXPERTS - 1)

    def expert_block(args):
        tok, wt, e = args
        xb = xt[tok]
        h = jax.nn.silu(xb @ w1[e]) * (xb @ w3[e])
        return (h @ w2[e]) * wt[:, None].astype(xt.dtype)

    out = lax.map(expert_block, (buf_t.reshape(n_blocks, MOE_BLOCK), buf_w.reshape(n_blocks, MOE_BLOCK), blk_e))
    y = jnp.zeros_like(xt).at[buf_t].add(out.reshape(n_rows, d))
    return y.reshape(b, s, d)


def setup_inputs(seed: int = 0) -> dict:
    key = jax.random.key(seed)
    ks = iter(jax.random.split(key, 40))

    def nrm(shape, scale):
        return jax.random.normal(next(ks), shape, jnp.float32) * scale

    x = nrm((BATCH, SEQ, D_MODEL), 1.0)
    mix_norm = 1.0 + nrm((DEPTH, D_MODEL), 0.02)
    ffn_norm = 1.0 + nrm((DEPTH, D_MODEL), 0.02)
    final_norm = 1.0 + nrm((D_MODEL,), 0.02)
    na, nb = N_A_LAYERS, N_B_LAYERS
    a_w_in = nrm((na, D_MODEL, 2 * D_RNN), D_MODEL ** -0.5)
    a_conv_w = nrm((na, CONV_WIDTH, D_RNN), CONV_WIDTH ** -0.5)
    a_conv_b = nrm((na, D_RNN), 0.01)
    a_gate_a_w = nrm((na, LRU_HEADS, LRU_HEAD_DIM, LRU_HEAD_DIM), LRU_HEAD_DIM ** -0.5)
    a_gate_a_b = nrm((na, LRU_HEADS, LRU_HEAD_DIM), 0.01)
    a_gate_x_w = nrm((na, LRU_HEADS, LRU_HEAD_DIM, LRU_HEAD_DIM), LRU_HEAD_DIM ** -0.5)
    a_gate_x_b = nrm((na, LRU_HEADS, LRU_HEAD_DIM), 0.01)
    u = jax.random.uniform(next(ks), (na, D_RNN), jnp.float32, 0.9, 0.999)
    sg = u ** (1.0 / LRU_C)
    a_lru_L = jnp.log(sg) - jnp.log1p(-sg)
    a_w_out = nrm((na, D_RNN, D_MODEL), D_RNN ** -0.5)
    b_w_in = nrm((nb, D_MODEL, D_SSM), D_MODEL ** -0.5)
    b_lam_re = -0.5 + nrm((nb, SSM_GROUPS, SSM_STATE), 0.01)
    b_lam_im = jnp.pi * jnp.arange(SSM_STATE, dtype=jnp.float32) + nrm((nb, SSM_GROUPS, SSM_STATE), 0.01)
    b_log_dt = jax.random.uniform(next(ks), (nb, SSM_GROUPS), jnp.float32, math.log(DT_MIN), math.log(DT_MAX))
    b_b_re = nrm((nb, SSM_GROUPS, SSM_STATE, SSM_GROUP), (2 * SSM_GROUP) ** -0.5)
    b_b_im = nrm((nb, SSM_GROUPS, SSM_STATE, SSM_GROUP), (2 * SSM_GROUP) ** -0.5)
    b_c_re = nrm((nb, SSM_GROUPS, SSM_GROUP, SSM_STATE), SSM_STATE ** -0.5)
    b_c_im = nrm((nb, SSM_GROUPS, SSM_GROUP, SSM_STATE), SSM_STATE ** -0.5)
    b_d = nrm((nb, D_SSM), 1.0)
    b_w_glu = nrm((nb, D_SSM, 2 * D_MODEL), D_SSM ** -0.5)
    moe_wg = nrm((DEPTH, D_MODEL, N_GROUPS), D_MODEL ** -0.5)
    moe_bg = nrm((DEPTH, N_GROUPS), 0.01)
    moe_we = nrm((DEPTH, N_GROUPS, D_MODEL, EXPERTS_PER_GROUP), D_MODEL ** -0.5)
    moe_be = nrm((DEPTH, N_GROUPS, EXPERTS_PER_GROUP), 0.01)
    moe_w1 = nrm((DEPTH, N_EXPERTS, D_MODEL, D_EXPERT), D_MODEL ** -0.5)
    moe_w3 = nrm((DEPTH, N_EXPERTS, D_MODEL, D_EXPERT), D_MODEL ** -0.5)
    moe_w2 = nrm((DEPTH, N_EXPERTS, D_EXPERT, D_MODEL), D_EXPERT ** -0.5)
    return {"x": x, "mix_norm": mix_norm, "ffn_norm": ffn_norm, "final_norm": final_norm,
            "a_w_in": a_w_in, "a_conv_w": a_conv_w, "a_conv_b": a_conv_b,
            "a_gate_a_w": a_gate_a_w, "a_gate_a_b": a_gate_a_b, "a_gate_x_w": a_gate_x_w,
            "a_gate_x_b": a_gate_x_b, "a_lru_L": a_lru_L, "a_w_out": a_w_out,
            "b_w_in": b_w_in, "b_lam_re": b_lam_re, "b_lam_im": b_lam_im, "b_log_dt": b_log_dt,
            "b_b_re": b_b_re, "b_b_im": b_b_im, "b_c_re": b_c_re, "b_c_im": b_c_im,
            "b_d": b_d, "b_w_glu": b_w_glu,
            "moe_wg": moe_wg, "moe_bg": moe_bg, "moe_we": moe_we, "moe_be": moe_be,
            "moe_w1": moe_w1, "moe_w3": moe_w3, "moe_w2": moe_w2}


def reference(x, mix_norm, ffn_norm, final_norm,
              a_w_in, a_conv_w, a_conv_b, a_gate_a_w, a_gate_a_b, a_gate_x_w, a_gate_x_b, a_lru_L, a_w_out,
              b_w_in, b_lam_re, b_lam_im, b_log_dt, b_b_re, b_b_im, b_c_re, b_c_im, b_d, b_w_glu,
              moe_wg, moe_bg, moe_we, moe_be, moe_w1, moe_w3, moe_w2):
    for layer in range(DEPTH):
        h = rms_norm(x, mix_norm[layer])
        j = layer // N_MIXERS
        if layer % N_MIXERS == 0:
            h = rglru_block(h, a_w_in[j], a_conv_w[j], a_conv_b[j], a_gate_a_w[j], a_gate_a_b[j],
                            a_gate_x_w[j], a_gate_x_b[j], a_lru_L[j], a_w_out[j])
        else:
            h = s5_block(h, b_w_in[j], b_lam_re[j], b_lam_im[j], b_log_dt[j], b_b_re[j], b_b_im[j],
                         b_c_re[j], b_c_im[j], b_d[j], b_w_glu[j])
        x = x + h
        x = x + hier_moe(rms_norm(x, ffn_norm[layer]), moe_wg[layer], moe_bg[layer], moe_we[layer],
                         moe_be[layer], moe_w1[layer], moe_w3[layer], moe_w2[layer])
    return rms_norm(x, final_norm)
```

```cpp
#include <hip/hip_runtime.h>
#include <cstdio>
#include <cstdint>

#ifndef MK_N_LAUNCHES
#define MK_N_LAUNCHES 1
#endif

#define LAS __attribute__((address_space(3)))
#define GAS __attribute__((address_space(1)))
typedef unsigned short bf16_t;
typedef short bf16x8 __attribute__((ext_vector_type(8)));
typedef float f32x2 __attribute__((ext_vector_type(2)));
typedef float f32x4 __attribute__((ext_vector_type(4)));
typedef float f32x16 __attribute__((ext_vector_type(16)));
typedef unsigned u32x2 __attribute__((ext_vector_type(2)));
typedef unsigned u32x4 __attribute__((ext_vector_type(4)));

constexpr int SEQ = 16384, DM = 2048, DRNN = 2560, NHEAD = 16, HDIM = 160, DSSM = 1024, SGRP = 64, SST = 64;
constexpr int NEXP = 32, DEXP = 512;
constexpr float EPS = 1e-6f;
constexpr int NPH = 17;
constexpr int NWAVES = 8, NTHR = 512;

constexpr size_t MiB = 1u << 20;
constexpr size_t WS_CTL = 0, CTL_BYTES = 1 * MiB;
constexpr size_t WS_WR = 1 * MiB;
constexpr size_t WS_WG = 2 * MiB;
constexpr size_t WS_RSTD0 = 4 * MiB;
constexpr size_t WS_RSTD1 = 4 * MiB + 65536;
constexpr size_t WS_TOKSLOT = 4 * MiB + 131072;
constexpr size_t WS_PSUM = 5 * MiB;
constexpr size_t WS_ESUM = 5 * MiB + 1310720;
constexpr size_t WS_EEND = 8 * MiB;
constexpr size_t WS_LTOK = 10 * MiB, WS_LGATE = 12 * MiB, WS_LRS = 14 * MiB;
constexpr size_t WS_WINA = 16 * MiB, WS_WOUTA = 36 * MiB, WS_WINB = 46 * MiB, WS_WGLU = 50 * MiB, WS_W13 = 58 * MiB, WS_W2 = 314 * MiB;
constexpr size_t WS_XS = 442 * MiB, WS_G = 506 * MiB, WS_R = 586 * MiB, WS_HL = 666 * MiB, WS_CP = 746 * MiB, WS_END = 826 * MiB;
constexpr size_t WS_O = WS_G, WS_H = WS_HL, WS_U = WS_CP, WS_Z = WS_CP + 32 * MiB;
constexpr int CW_CNT = 64;
constexpr int CW_BAR = 4096;

constexpr int RING_BYTES = 131072;
constexpr int TOKL_OFF = RING_BYTES;
constexpr int TAB_OFF = TOKL_OFF + 16384;
constexpr int MISC_OFF = TAB_OFF + 512;
constexpr int LDS_BYTES = MISC_OFF + 256;

__device__ __forceinline__ unsigned cvt_pk_bf16(float lo, float hi) { unsigned r; asm volatile("v_cvt_pk_bf16_f32 %0, %1, %2" : "=v"(r) : "v"(lo), "v"(hi)); return r; }
__device__ __forceinline__ float bf_lo(unsigned w) { return __uint_as_float(w << 16); }
__device__ __forceinline__ float bf_hi(unsigned w) { return __uint_as_float(w & 0xffff0000u); }
__device__ __forceinline__ float bf2f(bf16_t b) { return __uint_as_float(((unsigned)b) << 16); }
__device__ __forceinline__ bf16_t f2bf(float f) { return (bf16_t)(cvt_pk_bf16(f, 0.f) & 0xffffu); }
__device__ __forceinline__ float fast_sigmoid(float z) { return __builtin_amdgcn_rcpf(1.0f + __builtin_amdgcn_exp2f(-1.44269504089f * z)); }
__device__ __forceinline__ float gelu_tanh(float x) { const float u = 1.5957691216f * (x + 0.044715f * x * x * x); return x * fast_sigmoid(u); }
__device__ __forceinline__ float wave_sum(float v) {
#pragma unroll
    for (int o = 1; o < 64; o <<= 1) v += __shfl_xor(v, o);
    return v;
}
#define LDS_WAIT() asm volatile("s_waitcnt lgkmcnt(0)" ::: "memory")
#define VM_WAIT() asm volatile("s_waitcnt vmcnt(0)" ::: "memory")

#define XB_TMO      128
#define XB_XCNT(j)  (256  + 64 * (j))
#define XB_XSUB(j)  (1280 + 64 * (j))
#define XB_XGEN(j)  (2304 + 64 * (j))
#define XB_TOP      3328
#define XB_TOPGEN   3392
#define XCD_BAR_WORDS 3456
#define XB_SPIN_CAP (1u << 18)
__device__ __forceinline__ unsigned xb_ld(unsigned* p)              { return __hip_atomic_load(p, __ATOMIC_RELAXED, __HIP_MEMORY_SCOPE_AGENT); }
__device__ __forceinline__ unsigned xb_add(unsigned* p, unsigned v) { return __hip_atomic_fetch_add(p, v, __ATOMIC_RELAXED, __HIP_MEMORY_SCOPE_AGENT); }
__device__ __forceinline__ unsigned xb_xcc_id() { return (unsigned)__builtin_amdgcn_s_getreg((3 << 11) | 20) & 0xFu; }
#define XB_SPIN(cond, bar) do { unsigned _sp = 0; while (cond) { __builtin_amdgcn_s_sleep(1); \
    if ((++_sp & 255u) == 0u) { if (xb_ld(&(bar)[XB_TMO])) break; if (_sp > XB_SPIN_CAP) { atomicAdd(&(bar)[XB_TMO], 1u); break; } } } } while (0)
struct XcdBarrier { unsigned* bar; unsigned x; volatile LAS unsigned* st; };
__device__ __forceinline__ XcdBarrier xcd_barrier_post(unsigned* bar, volatile LAS unsigned* st) {
    XcdBarrier b; b.bar = bar; b.x = xb_xcc_id(); b.st = st;
    if (threadIdx.x == 0) (void)xb_add(&bar[XB_XCNT(b.x)], 1u);
    return b;
}
__device__ __forceinline__ void xcd_barrier_complete(unsigned* bar, unsigned x, unsigned& nloc, unsigned& nx) {
    const unsigned G = gridDim.x * gridDim.y * gridDim.z;
    unsigned sum, cnt, mine, sp = 0u;
    for (;;) {
        sum = 0u; cnt = 0u; mine = 0u;
#pragma unroll
        for (unsigned j = 0; j < 16; ++j) { const unsigned c = xb_ld(&bar[XB_XCNT(j)]); sum += c; cnt += (c > 0u) ? 1u : 0u; mine = (j == x) ? c : mine; }
        if (sum == G) break;
        __builtin_amdgcn_s_sleep(1);
        if ((++sp & 255u) == 0u) { if (xb_ld(&bar[XB_TMO])) break; if (sp > XB_SPIN_CAP) { atomicAdd(&bar[XB_TMO], 1u); break; } }
    }
    nloc = mine > 0u ? mine : 1u; nx = cnt > 0u ? cnt : 1u;
}
__device__ __forceinline__ void xcd_barrier(const XcdBarrier& b) {
    asm volatile("s_waitcnt vmcnt(0)" ::: "memory");
    __syncthreads();
    if (threadIdx.x == 0) {
        unsigned* bar = b.bar;
        __builtin_amdgcn_s_waitcnt(0);
        unsigned nloc = b.st[0], nx = b.st[1];
        if (nloc == 0u) { xcd_barrier_complete(bar, b.x, nloc, nx); b.st[0] = nloc; b.st[1] = nx; }
        const unsigned old = xb_add(&bar[XB_XSUB(b.x)], 1u);
        const unsigned gen = old / nloc;
        if (old + 1u == (gen + 1u) * nloc) {
            __builtin_amdgcn_fence(__ATOMIC_RELEASE, "agent");
            asm volatile("s_waitcnt vmcnt(0)" ::: "memory");
            const unsigned og = xb_add(&bar[XB_TOP], 1u);
            const unsigned tg = og / nx;
            if (og + 1u == (tg + 1u) * nx) xb_add(&bar[XB_TOPGEN], 1u);
            else XB_SPIN(xb_ld(&bar[XB_TOPGEN]) == tg, bar);
            __builtin_amdgcn_fence(__ATOMIC_ACQUIRE, "agent");
            xb_add(&bar[XB_XGEN(b.x)], 1u);
            asm volatile("s_waitcnt vmcnt(0)" ::: "memory");
        } else {
            XB_SPIN(xb_ld(&bar[XB_XGEN(b.x)]) == gen, bar);
            __builtin_amdgcn_fence(__ATOMIC_ACQUIRE, "agent");
            asm volatile("s_waitcnt vmcnt(0)" ::: "memory");
        }
    }
    __syncthreads();
}

namespace pg8 {
constexpr int BM = 256, BK = 64, HALF = 128, HTB = HALF * BK * 2, STAGE_BYTES = 8 * HTB, NXCD = 8, WGM = 8;
__host__ __device__ __forceinline__ int lds_byte(int r, int c) { const int st = (r >> 4) * 2 + (c >> 5), rr = r & 15, cc = c & 31, ob = rr * 64 + cc * 2; return st * 1024 + (ob ^ (((ob >> 9) & 1) << 5)); }
__host__ __device__ __forceinline__ void stage_rc(int b, int& R, int& C) { const int st = b / 1024, sb = b % 1024, swz = sb ^ (((sb >> 9) & 1) << 5); R = (st >> 1) * 16 + swz / 64; C = (st & 1) * 32 + (swz % 64) / 2; }
__host__ __device__ __forceinline__ int perm32(int rho) { const int n = rho >> 4, i = rho & 15; return 8 * (i >> 2) + 4 * n + (i & 3); }

struct Unit { int pm, pn, e, rows, hrow0, slot, lrow0; };

struct DenseSched {
    const char* A; const char* Bt; int K; int nM, nN, nwg, G, c;
    __device__ void init(const void* A_, const void* Bt_, int M, int N, int K_, int G_, int c_) { A = (const char*)A_; Bt = (const char*)Bt_; K = K_; nM = M / BM; nN = N / BM; nwg = nM * nN; G = G_; c = c_; }
    __device__ __forceinline__ bool next(int i, Unit& u) const {
        const long L = (long)i * G + c; if (L >= nwg) return false;
        int wgid = (int)L; { const int q = nwg / NXCD, r = nwg % NXCD, xcd = wgid % NXCD, off = wgid / NXCD; wgid = (xcd < r ? xcd * (q + 1) : r * (q + 1) + (xcd - r) * q) + off; }
        const int nig = WGM * nN, gid = wgid / nig, fm = gid * WGM, gsz = (nM - fm) < WGM ? (nM - fm) : WGM;
        u.pm = fm + ((wgid % nig) % gsz); u.pn = (wgid % nig) / gsz; u.e = 0; u.rows = 256; u.hrow0 = 0; u.slot = 0; u.lrow0 = 0; return true;
    }
    __device__ __forceinline__ int b_off(const Unit& u) const { return u.pn * BM * K * 2; }
    __device__ __forceinline__ void a_off(const Unit& u, unsigned (&off)[2][2]) const {
#pragma unroll
        for (int i = 0; i < 2; ++i) { int R, C; stage_rc((int)threadIdx.x * 16 + i * 8192, R, C);
#pragma unroll
            for (int h = 0; h < 2; ++h) off[h][i] = (unsigned)((u.pm * BM + h * HALF + R) * K + C) * 2u; }
    }
};
template <bool GATHER> struct MoeSched {
    const char* A; const char* Bt; int K; int NPN; size_t bstride; int x, rank, nrank; const LAS int* tab; const LAS int* tokL; int cum[5];
    __device__ void init(const void* A_, const void* Bt_, int K_, int NPN_, size_t bstride_, const LAS int* tab_, const LAS int* tokL_) {
        A = (const char*)A_; Bt = (const char*)Bt_; K = K_; NPN = NPN_; bstride = bstride_; tab = tab_; tokL = tokL_;
        const int G = gridDim.x, b = blockIdx.x; x = b & 7; rank = b >> 3; nrank = (G - x + 7) >> 3;
        cum[0] = 0;
#pragma unroll
        for (int j = 0; j < 4; ++j) { const int c = __builtin_amdgcn_readfirstlane(tab[x + 8 * j]); cum[j + 1] = cum[j] + ((c + 255) >> 8); }
    }
    __device__ __forceinline__ bool next(int i, Unit& u) const {
        const int L = i * nrank + rank; const int tl = L / NPN; if (tl >= cum[4]) return false;
        const int j = (tl >= cum[1]) + (tl >= cum[2]) + (tl >= cum[3]);
        const int cj = j == 0 ? cum[0] : j == 1 ? cum[1] : j == 2 ? cum[2] : cum[3];
        u.e = x + 8 * j; u.pm = tl - cj; u.pn = L - tl * NPN;
        const int c = __builtin_amdgcn_readfirstlane(tab[u.e]); const int rem = c - 256 * u.pm; u.rows = rem < 256 ? rem : 256; u.lrow0 = 256 * u.pm;
        u.hrow0 = (__builtin_amdgcn_readfirstlane(tab[32 + u.e]) + u.pm) * 256; u.slot = i; return true;
    }
    __device__ __forceinline__ int b_off(const Unit& u) const { return u.e * (int)bstride + u.pn * BM * K * 2; }
    __device__ __forceinline__ void a_off(const Unit& u, unsigned (&off)[2][2]) const {
#pragma unroll
        for (int i = 0; i < 2; ++i) { int R, C; stage_rc((int)threadIdx.x * 16 + i * 8192, R, C);
#pragma unroll
            for (int h = 0; h < 2; ++h) {
                if (GATHER) { const int tok = tokL[(u.slot & 15) * 256 + h * HALF + R]; off[h][i] = (unsigned)(tok * K + C) * 2u; }
                else off[h][i] = (unsigned)((u.hrow0 + h * HALF + R) * K + C) * 2u; } }
    }
};

template <class Epi, class Sched>
__device__ __forceinline__ void gemm_phase(LAS unsigned char* lds, const Sched& S, const Epi& E) {
    const int tid = threadIdx.x, wid = __builtin_amdgcn_readfirstlane(tid >> 6), lane = tid & 63, wr = wid >> 2, wc = wid & 3, fr = lane & 15, fq = lane >> 4;
    const int K = S.K, nt = K / BK;
    unsigned voffB[2];
#pragma unroll
    for (int i = 0; i < 2; ++i) { int R, C; stage_rc(tid * 16 + i * 8192, R, C); const int Rb = (R & ~31) + perm32(R & 31); voffB[i] = (unsigned)(Rb * K + C) * 2u; }
    const int kstep = BK * 2;
    const int hstep = HALF * K * 2;
    const unsigned ldsw = (unsigned)wid * 1024u;
    const int aoff = lds_byte(wr * 64 + fr, fq * 8), boff = lds_byte(wc * 32 + fr, fq * 8);
    const __amdgpu_buffer_rsrc_t rA = __builtin_amdgcn_make_buffer_rsrc((void*)S.A, 0, 0x7fffffff, 0x00020000);
    const __amdgpu_buffer_rsrc_t rB = __builtin_amdgcn_make_buffer_rsrc((void*)S.Bt, 0, 0x7fffffff, 0x00020000);
#define PG8_SA(b, h) (((b) * 2 + (h)) * HTB)
#define PG8_SB(b, h) ((4 + (b) * 2 + (h)) * HTB)
#define PG8_STAGE(bufoff, rsrc, voff, soff) do { _Pragma("unroll") for (int _i = 0; _i < 2; ++_i) \
        __builtin_amdgcn_raw_ptr_buffer_load_lds(rsrc, (LAS void*)(lds + (bufoff) + ldsw + _i * 8192), 16, (int)(voff)[_i], (int)(soff), 0, 0); } while (0)
#define PG8_LDA(dst, b, h) do { _Pragma("unroll") for (int m = 0; m < 4; ++m) _Pragma("unroll") for (int k = 0; k < 2; ++k) dst[m][k] = *(const LAS bf16x8*)(lds + PG8_SA(b, h) + aoff + m * 2048 + k * 1024); } while (0)
#define PG8_LDB(dst, b, h) do { _Pragma("unroll") for (int n = 0; n < 2; ++n) _Pragma("unroll") for (int k = 0; k < 2; ++k) dst[n][k] = *(const LAS bf16x8*)(lds + PG8_SB(b, h) + boff + n * 2048 + k * 1024); } while (0)
#define PG8_MMA(ai, bj, At, Bt) do { __builtin_amdgcn_s_setprio(1); _Pragma("unroll") for (int m = 0; m < 4; ++m) _Pragma("unroll") for (int n = 0; n < 2; ++n) _Pragma("unroll") for (int k = 0; k < 2; ++k) \
        acc[ai][bj][m][n] = __builtin_amdgcn_mfma_f32_16x16x32_bf16(Bt[n][k], At[m][k], acc[ai][bj][m][n], 0, 0, 0); __builtin_amdgcn_s_setprio(0); } while (0)
#define PG8_WAIT_V(n) asm volatile("s_waitcnt vmcnt(" #n ")" ::: "memory")
#define PG8_WAIT_L(n) asm volatile("s_waitcnt lgkmcnt(" #n ")" ::: "memory")
#define PG8_BAR __builtin_amdgcn_s_barrier()
#define PG8_SCHED __builtin_amdgcn_sched_barrier(0)
    Unit cur, nxt; int ui = 0;
    if (!S.next(0, cur)) return;
    f32x4 acc[2][2][4][2];
#pragma unroll
    for (int a = 0; a < 2; ++a)
#pragma unroll
        for (int b = 0; b < 2; ++b)
#pragma unroll
            for (int m = 0; m < 4; ++m)
#pragma unroll
                for (int n = 0; n < 2; ++n) acc[a][b][m][n] = (f32x4){0.f, 0.f, 0.f, 0.f};
    bf16x8 At[4][2], B0[2][2], B1[2][2];
    unsigned oC[2][2];
    S.a_off(cur, oC);
    int cB = S.b_off(cur);
    PG8_STAGE(PG8_SB(0, 0), rB, voffB, cB); PG8_STAGE(PG8_SB(0, 1), rB, voffB, cB + hstep); PG8_STAGE(PG8_SA(0, 0), rA, oC[0], 0); PG8_STAGE(PG8_SA(0, 1), rA, oC[1], 0);
    if (wr == 1) PG8_BAR;
    PG8_WAIT_V(2); PG8_BAR;
    PG8_STAGE(PG8_SB(1, 0), rB, voffB, cB + kstep); PG8_STAGE(PG8_SA(1, 0), rA, oC[0], kstep); PG8_STAGE(PG8_SB(1, 1), rB, voffB, cB + hstep + kstep);
    PG8_WAIT_V(6); PG8_BAR;
    for (;;) {
        const bool has_next = S.next(ui + 1, nxt);
        const int nB = has_next ? S.b_off(nxt) : cB;
        for (int t = 0; t < nt; t += 2) {
            const bool last = (t == nt - 2);
            const int a1 = (t + 1) * kstep;
            const int a2 = last ? 0 : (t + 2) * kstep, b2 = last ? nB : cB + (t + 2) * kstep;
            const int a3 = a2 + kstep, b3 = b2 + kstep;
            PG8_LDB(B0, 0, 0); PG8_LDB(B1, 0, 1); PG8_SCHED; PG8_LDA(At, 0, 0); PG8_STAGE(PG8_SA(1, 1), rA, oC[1], a1);
            if (last && has_next) S.a_off(nxt, oC);
            PG8_WAIT_V(8); PG8_WAIT_L(0); PG8_BAR; PG8_MMA(0, 0, At, B0); PG8_MMA(0, 1, At, B1); PG8_BAR; PG8_SCHED;
            PG8_LDA(At, 0, 1); PG8_STAGE(PG8_SB(0, 0), rB, voffB, b2); PG8_STAGE(PG8_SB(0, 1), rB, voffB, b2 + hstep); PG8_STAGE(PG8_SA(0, 0), rA, oC[0], a2);
            PG8_WAIT_V(8); PG8_WAIT_L(0); PG8_BAR; PG8_MMA(1, 0, At, B0); PG8_MMA(1, 1, At, B1); PG8_BAR; PG8_SCHED;
            PG8_LDB(B0, 1, 0); PG8_LDB(B1, 1, 1); PG8_SCHED; PG8_LDA(At, 1, 0); PG8_STAGE(PG8_SA(0, 1), rA, oC[1], a2);
            PG8_WAIT_V(8); PG8_WAIT_L(0); PG8_BAR; PG8_MMA(0, 0, At, B0); PG8_MMA(0, 1, At, B1); PG8_BAR; PG8_SCHED;
            PG8_LDA(At, 1, 1); PG8_STAGE(PG8_SB(1, 0), rB, voffB, b3); PG8_STAGE(PG8_SB(1, 1), rB, voffB, b3 + hstep); PG8_STAGE(PG8_SA(1, 0), rA, oC[0], a3);
            PG8_WAIT_V(8); PG8_WAIT_L(0); PG8_BAR; PG8_MMA(1, 0, At, B0); PG8_MMA(1, 1, At, B1); PG8_BAR; PG8_SCHED;
        }
        if (wr == 0) PG8_BAR;
        E(acc, cur, wr, wc, fr, fq);
        if (!has_next) break;
#pragma unroll
        for (int a = 0; a < 2; ++a)
#pragma unroll
            for (int b = 0; b < 2; ++b)
#pragma unroll
                for (int m = 0; m < 4; ++m)
#pragma unroll
                    for (int n = 0; n < 2; ++n) acc[a][b][m][n] = (f32x4){0.f, 0.f, 0.f, 0.f};
        cur = nxt; cB = nB; ++ui;
        if (wr == 1) PG8_BAR;
    }
    PG8_WAIT_V(0);
    PG8_BAR;
#undef PG8_SA
#undef PG8_SB
#undef PG8_STAGE
#undef PG8_LDA
#undef PG8_LDB
#undef PG8_MMA
#undef PG8_WAIT_V
#undef PG8_WAIT_L
#undef PG8_BAR
#undef PG8_SCHED
}
}
using pg8::Unit;

typedef const f32x4 (&AccRef)[2][2][4][2];
__device__ __forceinline__ u32x4 pack8(const f32x4 a, const f32x4 b) { u32x4 w; w.x = cvt_pk_bf16(a[0], a[1]); w.y = cvt_pk_bf16(a[2], a[3]); w.z = cvt_pk_bf16(b[0], b[1]); w.w = cvt_pk_bf16(b[2], b[3]); return w; }
__device__ __forceinline__ void unpack8(const u32x4 w, f32x4& a, f32x4& b) { a = (f32x4){bf_lo(w.x), bf_hi(w.x), bf_lo(w.y), bf_hi(w.y)}; b = (f32x4){bf_lo(w.z), bf_hi(w.z), bf_lo(w.w), bf_hi(w.w)}; }

struct EpiG1 {
    bf16_t* Gb; bf16_t* Rb; const float* rstd;
    __device__ __forceinline__ void operator()(AccRef acc, const Unit& u, int wr, int wc, int fr, int fq) const {
        const bool isg = u.pn < 10; bf16_t* base = isg ? Gb + u.pn * 256 : Rb + (u.pn - 10) * 256;
#pragma unroll
        for (int ai = 0; ai < 2; ++ai)
#pragma unroll
            for (int m = 0; m < 4; ++m) { const int row = u.pm * 256 + ai * 128 + wr * 64 + m * 16 + fr; const float s = rstd[row]; bf16_t* rowp = base + (size_t)row * DRNN + wc * 32 + 8 * fq;
#pragma unroll
                for (int bj = 0; bj < 2; ++bj) { f32x4 v0 = acc[ai][bj][m][0] * s, v1 = acc[ai][bj][m][1] * s;
                    if (isg) {
#pragma unroll
                        for (int j = 0; j < 4; ++j) { v0[j] = gelu_tanh(v0[j]); v1[j] = gelu_tanh(v1[j]); } }
                    *(u32x4*)(rowp + bj * 128) = pack8(v0, v1); } }
    }
};
struct EpiRes {
    bf16_t* XS;
    __device__ __forceinline__ void operator()(AccRef acc, const Unit& u, int wr, int wc, int fr, int fq) const {
#pragma unroll
        for (int ai = 0; ai < 2; ++ai)
#pragma unroll
            for (int m = 0; m < 4; ++m) { const int row = u.pm * 256 + ai * 128 + wr * 64 + m * 16 + fr; bf16_t* rowp = XS + (size_t)row * DM + u.pn * 256 + wc * 32 + 8 * fq;
#pragma unroll
                for (int bj = 0; bj < 2; ++bj) { const u32x4 old = *(const u32x4*)(rowp + bj * 128); f32x4 o0, o1; unpack8(old, o0, o1);
                    *(u32x4*)(rowp + bj * 128) = pack8(o0 + acc[ai][bj][m][0], o1 + acc[ai][bj][m][1]); } }
    }
};
struct EpiScale {
    bf16_t* U; int ldc; const float* rstd;
    __device__ __forceinline__ void operator()(AccRef acc, const Unit& u, int wr, int wc, int fr, int fq) const {
#pragma unroll
        for (int ai = 0; ai < 2; ++ai)
#pragma unroll
            for (int m = 0; m < 4; ++m) { const int row = u.pm * 256 + ai * 128 + wr * 64 + m * 16 + fr; const float s = rstd[row]; bf16_t* rowp = U + (size_t)row * ldc + u.pn * 256 + wc * 32 + 8 * fq;
#pragma unroll
                for (int bj = 0; bj < 2; ++bj) *(u32x4*)(rowp + bj * 128) = pack8(acc[ai][bj][m][0] * s, acc[ai][bj][m][1] * s); }
    }
};
struct EpiGlu {
    bf16_t* XS;
    __device__ __forceinline__ void operator()(AccRef acc, const Unit& u, int wr, int wc, int fr, int fq) const {
#pragma unroll
        for (int ai = 0; ai < 2; ++ai)
#pragma unroll
            for (int m = 0; m < 4; ++m) { const int row = u.pm * 256 + ai * 128 + wr * 64 + m * 16 + fr; bf16_t* rowp = XS + (size_t)row * DM + u.pn * 128 + wc * 32 + 8 * fq;
                const u32x4 old = *(const u32x4*)rowp; f32x4 o0, o1; unpack8(old, o0, o1);
#pragma unroll
                for (int j = 0; j < 4; ++j) { o0[j] += acc[ai][0][m][0][j] * fast_sigmoid(acc[ai][1][m][0][j]); o1[j] += acc[ai][0][m][1][j] * fast_sigmoid(acc[ai][1][m][1][j]); }
                *(u32x4*)rowp = pack8(o0, o1); }
    }
};
struct EpiE1 {
    bf16_t* H; const float* lrs;
    __device__ __forceinline__ void operator()(AccRef acc, const Unit& u, int wr, int wc, int fr, int fq) const {
#pragma unroll
        for (int ai = 0; ai < 2; ++ai)
#pragma unroll
            for (int m = 0; m < 4; ++m) { const int lr = ai * 128 + wr * 64 + m * 16 + fr;
                if (lr < u.rows) { const float s = lrs[u.e * SEQ + u.lrow0 + lr]; bf16_t* rowp = H + (size_t)(u.hrow0 + lr) * DEXP + u.pn * 128 + wc * 32 + 8 * fq;
                    f32x4 h0, h1;
#pragma unroll
                    for (int j = 0; j < 4; ++j) { const float a0 = acc[ai][0][m][0][j] * s, b0 = acc[ai][1][m][0][j] * s, a1 = acc[ai][0][m][1][j] * s, b1 = acc[ai][1][m][1][j] * s;
                        h0[j] = a0 * fast_sigmoid(a0) * b0; h1[j] = a1 * fast_sigmoid(a1) * b1; }
                    *(u32x4*)rowp = pack8(h0, h1); } }
    }
};
struct EpiE2 {
    bf16_t* O; const float* lgate;
    __device__ __forceinline__ void operator()(AccRef acc, const Unit& u, int wr, int wc, int fr, int fq) const {
#pragma unroll
        for (int ai = 0; ai < 2; ++ai)
#pragma unroll
            for (int m = 0; m < 4; ++m) { const int lr = ai * 128 + wr * 64 + m * 16 + fr;
                if (lr < u.rows) { const float s = lgate[u.e * SEQ + u.lrow0 + lr]; bf16_t* rowp = O + (size_t)(u.hrow0 + lr) * DM + u.pn * 256 + wc * 32 + 8 * fq;
#pragma unroll
                    for (int bj = 0; bj < 2; ++bj) *(u32x4*)(rowp + bj * 128) = pack8(acc[ai][bj][m][0] * s, acc[ai][bj][m][1] * s); } }
    }
};

struct Args { const float* in[30]; float* out; unsigned char* ws; int ph_lo, ph_hi; };
struct Frame { LAS unsigned char* lds; int tid, lane, wave, G; unsigned char* ws; };

__device__ __forceinline__ void tr_item(const float* __restrict__ W, int ldw, int k0, int n0, const float* __restrict__ gain, bf16_t* __restrict__ WT, int K, int drow0, LAS float* scr, int lane) {
    f32x4 v[16];
    const int lr = lane >> 4, lc = lane & 15;
#pragma unroll
    for (int it = 0; it < 16; ++it) v[it] = *(const f32x4*)(W + (size_t)(k0 + 4 * it + lr) * ldw + n0 + 4 * lc);
#pragma unroll
    for (int it = 0; it < 16; ++it) { const int k = 4 * it + lr; f32x4 x = v[it]; if (gain) x = x * gain[k0 + k];
        *(LAS f32x4*)(scr + k * 64 + ((4 * lc) ^ (4 * ((k >> 3) & 7)))) = x; }
    LDS_WAIT();
    const int c = lane & 7, nn = lane >> 3;
#pragma unroll
    for (int j = 0; j < 8; ++j) { const int n = 8 * j + nn; const LAS float* s = scr + (8 * c) * 64 + (n ^ (4 * c));
        u32x4 o; o.x = cvt_pk_bf16(s[0], s[64]); o.y = cvt_pk_bf16(s[128], s[192]); o.z = cvt_pk_bf16(s[256], s[320]); o.w = cvt_pk_bf16(s[384], s[448]);
        *(u32x4*)(WT + (size_t)(drow0 + n) * K + k0 + 8 * c) = o; }
    LDS_WAIT();
}
__device__ __forceinline__ void p0_prologue(const Frame& F, const Args& AR) {
    unsigned char* ws = F.ws;
    LAS float* scr = (LAS float*)(F.lds + F.wave * 16384);
    const int gw = blockIdx.x * NWAVES + F.wave, NGW = F.G * NWAVES;
    constexpr int I_WINA = 32 * 80, I_WOUTA = 40 * 32, I_WINB = 32 * 16, I_WGLU = 16 * 64, I_W1 = 64 * 256, I_W3 = I_W1, I_W2 = 64 * 256;
    constexpr int NITEMS = I_WINA + I_WOUTA + I_WINB + I_WGLU + I_W1 + I_W3 + I_W2;
    for (int it = gw; it < NITEMS; it += NGW) {
        int r = it;
        if (r < I_WINA) { const int kb = r / 80, nb = r % 80; tr_item(AR.in[4], 5120, 64 * kb, 64 * nb, AR.in[1], (bf16_t*)(ws + WS_WINA), 2048, 64 * nb, scr, F.lane); continue; } r -= I_WINA;
        if (r < I_WOUTA) { const int kb = r / 32, nb = r % 32; tr_item(AR.in[12], 2048, 64 * kb, 64 * nb, nullptr, (bf16_t*)(ws + WS_WOUTA), 2560, 64 * nb, scr, F.lane); continue; } r -= I_WOUTA;
        if (r < I_WINB) { const int kb = r / 16, nb = r % 16; tr_item(AR.in[13], 1024, 64 * kb, 64 * nb, AR.in[1] + 2048, (bf16_t*)(ws + WS_WINB), 2048, 64 * nb, scr, F.lane); continue; } r -= I_WINB;
        if (r < I_WGLU) { const int kb = r / 64, nb = r % 64; const int n0 = 64 * nb; const int nn = n0 & 2047; const int drow = 256 * (nn >> 7) + (nn & 127) + (n0 >= 2048 ? 128 : 0);
            tr_item(AR.in[22], 4096, 64 * kb, n0, nullptr, (bf16_t*)(ws + WS_WGLU), 1024, drow, scr, F.lane); continue; } r -= I_WGLU;
        if (r < I_W1 + I_W3) { const int which = r >= I_W1; if (which) r -= I_W1; const int mat = r >> 8, q = r & 255, kb = q >> 3, nb = q & 7, n0 = 64 * nb; const int l = mat >> 5;
            tr_item((which ? AR.in[28] : AR.in[27]) + (size_t)mat * 2048 * 512, 512, 64 * kb, n0, AR.in[2] + 2048 * l, (bf16_t*)(ws + WS_W13) + (size_t)mat * 1024 * 2048, 2048, 256 * (n0 >> 7) + (n0 & 127) + 128 * which, scr, F.lane); continue; } r -= I_W1 + I_W3;
        { const int mat = r >> 8, q = r & 255, kb = q >> 5, nb = q & 31;
            tr_item(AR.in[29] + (size_t)mat * 512 * 2048, 2048, 64 * kb, 64 * nb, nullptr, (bf16_t*)(ws + WS_W2) + (size_t)mat * 2048 * 512, 512, 64 * nb, scr, F.lane); }
    }
    const int gt = blockIdx.x * NTHR + F.tid, NGT = F.G * NTHR;
    { bf16_t* WR = (bf16_t*)(ws + WS_WR);
      for (int i = gt; i < 2 * 48 * 2048; i += NGT) { const int l = i / (48 * 2048), j = (i / 2048) % 48, k = i % 2048; float v = 0.f;
          if (j < 4) v = AR.in[23][((size_t)l * 2048 + k) * 4 + j]; else if (j < 36) { const int g = (j - 4) >> 3, e = (j - 4) & 7; v = AR.in[25][(((size_t)l * 4 + g) * 2048 + k) * 8 + e]; }
          WR[i] = f2bf(v * AR.in[2][l * 2048 + k]); } }
    { bf16_t* WG = (bf16_t*)(ws + WS_WG);
      for (int i = gt; i < 16 * 320 * 160; i += NGT) { const int h = i / (320 * 160), n = (i / 160) % 320, k = i % 160;
          const float v = n < 160 ? AR.in[7][((size_t)h * 160 + k) * 160 + n] : AR.in[9][((size_t)h * 160 + k) * 160 + (n - 160)]; WG[i] = f2bf(v); } }
    for (int m = gw; m < SEQ; m += NGW) {
        const f32x4* xr = (const f32x4*)(AR.in[0] + (size_t)m * DM) + F.lane; f32x4 v[8]; float s = 0.f;
#pragma unroll
        for (int j = 0; j < 8; ++j) { v[j] = xr[64 * j]; s += (v[j].x * v[j].x + v[j].y * v[j].y) + (v[j].z * v[j].z + v[j].w * v[j].w); }
        s = wave_sum(s);
        u32x2* o = (u32x2*)((bf16_t*)(ws + WS_XS) + (size_t)m * DM) + F.lane;
#pragma unroll
        for (int j = 0; j < 8; ++j) { u32x2 w; w.x = cvt_pk_bf16(v[j].x, v[j].y); w.y = cvt_pk_bf16(v[j].z, v[j].w); o[64 * j] = w; }
        if (F.lane == 0) ((float*)(ws + WS_RSTD0))[m] = 1.0f / sqrtf(s * (1.0f / DM) + EPS);
    }
}

constexpr int A1_WPITCH = 336, A1_CW_OFF = 320 * A1_WPITCH, A1_CB_OFF = A1_CW_OFF + 4 * 160 * 4;
__device__ __forceinline__ void a1_phase(const Frame& F, const Args& AR) {
    unsigned char* ws = F.ws;
    const bf16_t* Rb = (const bf16_t*)(ws + WS_R); bf16_t* HL = (bf16_t*)(ws + WS_HL); bf16_t* CP = (bf16_t*)(ws + WS_CP);
    float* PS = (float*)(ws + WS_PSUM); float* ES = (float*)(ws + WS_ESUM);
    const int lane = F.lane, q = lane & 31, hf = lane >> 5;
    for (int u = blockIdx.x; u < 256; u += F.G) {
        const int head = u & 15, rb = u >> 4;
        __syncthreads();
        { const u32x4* src = (const u32x4*)((const bf16_t*)(ws + WS_WG) + (size_t)head * 320 * 160);
          for (int i = F.tid; i < 320 * 20; i += NTHR) { const int n = i / 20, c = i % 20; *(LAS u32x4*)(F.lds + n * A1_WPITCH + c * 16) = src[i]; }
          for (int i = F.tid; i < 4 * 160; i += NTHR) ((LAS float*)(F.lds + A1_CW_OFF))[i] = AR.in[5][(i / 160) * DRNN + head * 160 + (i % 160)];
          for (int i = F.tid; i < 160; i += NTHR) ((LAS float*)(F.lds + A1_CB_OFF))[i] = AR.in[6][head * 160 + i]; }
        __syncthreads();
        const int run = rb * 8 + F.wave, t0 = run * 128;
        float ba[5], bx[5], cL[5], Hs[5], Cs[5];
#pragma unroll
        for (int ct = 0; ct < 5; ++ct) { const int ch = head * 160 + 32 * ct + q; ba[ct] = AR.in[8][ch]; bx[ct] = AR.in[10][ch]; cL[ct] = -8.0f * log1pf(expf(-AR.in[11][ch])); Hs[ct] = 0.f; Cs[ct] = 1.f; }
        bf16x8 id0, id1;
#pragma unroll
        for (int j = 0; j < 8; ++j) { id0[j] = (q == 8 * hf + j) ? (short)0x3F80 : (short)0; id1[j] = (q == 16 + 8 * hf + j) ? (short)0x3F80 : (short)0; }
        for (int sl = 0; sl < 4; ++sl) {
            const int ts = t0 + 32 * sl, tok = ts + q;
            bf16x8 Af[10];
#pragma unroll
            for (int kk = 0; kk < 10; ++kk) {
                const int c0 = 16 * kk + 8 * hf;
                f32x4 a0 = *(const LAS f32x4*)(F.lds + A1_CB_OFF + c0 * 4), a1 = *(const LAS f32x4*)(F.lds + A1_CB_OFF + c0 * 4 + 16);
#pragma unroll
                for (int tp = 0; tp < 4; ++tp) { const int row = tok - 3 + tp;
                    u32x4 rv = (u32x4){0u, 0u, 0u, 0u}; if (row >= 0) rv = *(const u32x4*)(Rb + (size_t)row * DRNN + head * 160 + c0);
                    const f32x4 w0 = *(const LAS f32x4*)(F.lds + A1_CW_OFF + (tp * 160 + c0) * 4), w1 = *(const LAS f32x4*)(F.lds + A1_CW_OFF + (tp * 160 + c0) * 4 + 16);
                    f32x4 r0, r1; unpack8(rv, r0, r1); a0 += r0 * w0; a1 += r1 * w1; }
                const u32x4 pk = pack8(a0, a1); Af[kk] = __builtin_bit_cast(bf16x8, pk);
            }
#pragma unroll
            for (int ct = 0; ct < 5; ++ct) {
                f32x16 ar, ai, ac;
#pragma unroll
                for (int i = 0; i < 16; ++i) { ar[i] = 0.f; ai[i] = 0.f; ac[i] = 0.f; }
#pragma unroll
                for (int kk = 0; kk < 10; ++kk) {
                    const bf16x8 bR = *(const LAS bf16x8*)(F.lds + (32 * ct + q) * A1_WPITCH + (16 * kk + 8 * hf) * 2);
                    const bf16x8 bI = *(const LAS bf16x8*)(F.lds + (160 + 32 * ct + q) * A1_WPITCH + (16 * kk + 8 * hf) * 2);
                    ar = __builtin_amdgcn_mfma_f32_32x32x16_bf16(Af[kk], bR, ar, 0, 0, 0);
                    ai = __builtin_amdgcn_mfma_f32_32x32x16_bf16(Af[kk], bI, ai, 0, 0, 0);
                }
                ac = __builtin_amdgcn_mfma_f32_32x32x16_bf16(Af[2 * ct], id0, ac, 0, 0, 0);
                ac = __builtin_amdgcn_mfma_f32_32x32x16_bf16(Af[2 * ct + 1], id1, ac, 0, 0, 0);
                float hl[16], cp[16], P[4], E[4];
#pragma unroll
                for (int rq = 0; rq < 4; ++rq) { float h = 0.f, c = 1.f;
#pragma unroll
                    for (int k = 0; k < 4; ++k) { const int i = 4 * rq + k;
                        const float r = fast_sigmoid(ar[i] + ba[ct]), ig = fast_sigmoid(ai[i] + bx[ct]);
                        const float a = __builtin_amdgcn_exp2f(1.44269504089f * cL[ct] * r);
                        const float bt = __builtin_amdgcn_sqrtf(fmaxf(1.0f - a * a, 0.f)) * ig * ac[i];
                        h = a * h + bt; c = c * a; hl[i] = h; cp[i] = c; }
                    P[rq] = c; E[rq] = h; }
                float Hc = Hs[ct], Cc = Cs[ct], Hin[4], Cin[4];
#pragma unroll
                for (int rq = 0; rq < 4; ++rq) { const float Po = __shfl_xor(P[rq], 32), Eo = __shfl_xor(E[rq], 32);
                    const float P0 = hf ? Po : P[rq], E0 = hf ? Eo : E[rq], P1 = hf ? P[rq] : Po, E1 = hf ? E[rq] : Eo;
                    const float H0 = Hc, C0 = Cc; Hc = P0 * Hc + E0; Cc = Cc * P0;
                    Hin[rq] = hf ? Hc : H0; Cin[rq] = hf ? Cc : C0;
                    Hc = P1 * Hc + E1; Cc = Cc * P1; }
                Hs[ct] = Hc; Cs[ct] = Cc;
#pragma unroll
                for (int i = 0; i < 16; ++i) { const int rq = i >> 2; const int t = ts + (i & 3) + 8 * rq + 4 * hf; const size_t o = (size_t)t * DRNN + head * 160 + 32 * ct + q;
                    HL[o] = f2bf(hl[i] + cp[i] * Hin[rq]); CP[o] = f2bf(cp[i] * Cin[rq]); }
            }
        }
        if (hf == 0) {
#pragma unroll
            for (int ct = 0; ct < 5; ++ct) { const int ch = head * 160 + 32 * ct + q; PS[(size_t)run * DRNN + ch] = Cs[ct]; ES[(size_t)run * DRNN + ch] = Hs[ct]; } }
    }
}
__device__ __forceinline__ void a2_phase(const Frame& F, const Args& AR) {
    unsigned char* ws = F.ws;
    const bf16_t* HL = (const bf16_t*)(ws + WS_HL); const bf16_t* CP = (const bf16_t*)(ws + WS_CP); const bf16_t* Gb = (const bf16_t*)(ws + WS_G); bf16_t* Y = (bf16_t*)(ws + WS_R);
    const float* PS = (const float*)(ws + WS_PSUM); const float* ES = (const float*)(ws + WS_ESUM);
    LAS float* car = (LAS float*)F.lds;
    for (int u = blockIdx.x; u < 256; u += F.G) {
        const int run = u >> 1, hfc = u & 1, ch0 = 1280 * hfc;
        __syncthreads();
        for (int p = F.tid; p < 640; p += NTHR) { f32x2 c = (f32x2){0.f, 0.f};
            for (int qq = 0; qq < run; ++qq) { const f32x2 Pq = *(const f32x2*)(PS + (size_t)qq * DRNN + ch0 + 2 * p), Eq = *(const f32x2*)(ES + (size_t)qq * DRNN + ch0 + 2 * p); c = Pq * c + Eq; }
            car[2 * p] = c.x; car[2 * p + 1] = c.y; }
        __syncthreads();
        for (int idx = F.tid; idx < 128 * 160; idx += NTHR) { const int t = idx / 160, v = idx % 160; const size_t o = (size_t)(run * 128 + t) * DRNN + ch0 + 8 * v;
            const u32x4 h4 = *(const u32x4*)(HL + o), c4 = *(const u32x4*)(CP + o), g4 = *(const u32x4*)(Gb + o);
            f32x4 h0, h1, c0, c1, g0, g1; unpack8(h4, h0, h1); unpack8(c4, c0, c1); unpack8(g4, g0, g1);
            const f32x4 k0 = *(const LAS f32x4*)(car + 8 * v), k1 = *(const LAS f32x4*)(car + 8 * v + 4);
            *(u32x4*)(Y + o) = pack8((h0 + c0 * k0) * g0, (h1 + c1 * k1) * g1); }
    }
}

__device__ __forceinline__ void router_phase(const Frame& F, const Args& AR, int layer) {
    unsigned char* ws = F.ws;
    const bf16_t* XS = (const bf16_t*)(ws + WS_XS); const bf16_t* WR = (const bf16_t*)(ws + WS_WR) + (size_t)layer * 48 * 2048;
    unsigned* gcnt = (unsigned*)(ws + WS_CTL) + CW_CNT + 32 * layer;
    int* ltok = (int*)(ws + WS_LTOK); float* lgate = (float*)(ws + WS_LGATE); float* lrs = (float*)(ws + WS_LRS); int* tslot = (int*)(ws + WS_TOKSLOT);
    LAS float* part = (LAS float*)F.lds;
    LAS float* ssqp = (LAS float*)(F.lds + 2 * 64 * 48 * 4);
    LAS int* hist = (LAS int*)(F.lds + 2 * 64 * 48 * 4 + 512);
    LAS int* base = hist + 32;
    const int lane = F.lane, mt = F.wave & 3, kh = F.wave >> 2, fr = lane & 15, fq = lane >> 4;
    for (int u = blockIdx.x; u < SEQ / 64; u += F.G) {
        __syncthreads();
        if (F.tid < 32) hist[F.tid] = 0;
        f32x4 acc[3]; acc[0] = acc[1] = acc[2] = (f32x4){0.f, 0.f, 0.f, 0.f}; float ssq = 0.f;
        const bf16_t* xrow = XS + (size_t)(64 * u + 16 * mt + fr) * DM + 1024 * kh + 8 * fq;
        const bf16_t* wrow = WR + (size_t)fr * DM + 1024 * kh + 8 * fq;
#pragma unroll 4
        for (int ks = 0; ks < 32; ++ks) {
            const u32x4 av = *(const u32x4*)(xrow + 32 * ks); f32x4 a0, a1; unpack8(av, a0, a1);
            ssq += (a0.x * a0.x + a0.y * a0.y) + (a0.z * a0.z + a0.w * a0.w) + (a1.x * a1.x + a1.y * a1.y) + (a1.z * a1.z + a1.w * a1.w);
            const bf16x8 af = __builtin_bit_cast(bf16x8, av);
#pragma unroll
            for (int n = 0; n < 3; ++n) { const bf16x8 bfg = *(const bf16x8*)(wrow + (size_t)n * 16 * DM + 32 * ks); acc[n] = __builtin_amdgcn_mfma_f32_16x16x32_bf16(af, bfg, acc[n], 0, 0, 0); }
        }
        ssq += __shfl_xor(ssq, 16); ssq += __shfl_xor(ssq, 32);
        if (fq == 0) ssqp[kh * 64 + 16 * mt + fr] = ssq;
#pragma unroll
        for (int n = 0; n < 3; ++n)
#pragma unroll
            for (int r = 0; r < 4; ++r) part[(kh * 64 + 16 * mt + 4 * fq + r) * 48 + 16 * n + fr] = acc[n][r];
        __syncthreads();
        int e0 = 0, e1 = 0, rk0 = 0, rk1 = 0; float g0 = 0.f, g1 = 0.f, rstd = 0.f;
        if (F.tid < 64) {
            const int t = F.tid; const LAS float* p0 = part + t * 48; const LAS float* p1 = part + (64 + t) * 48;
            rstd = 1.0f / sqrtf((ssqp[t] + ssqp[64 + t]) * (1.0f / DM) + EPS);
            float gl[4]; int gi = 0; float gm = -3.0e38f;
#pragma unroll
            for (int j = 0; j < 4; ++j) { gl[j] = (p0[j] + p1[j]) * rstd + AR.in[24][layer * 4 + j]; if (gl[j] > gm) { gm = gl[j]; gi = j; } }
            float gs = 0.f;
#pragma unroll
            for (int j = 0; j < 4; ++j) gs += expf(gl[j] - gm);
            const float pg = 1.0f / gs;
            float v0 = -3.0e38f, v1 = -3.0e38f; int i0 = 0, i1 = 0;
#pragma unroll
            for (int e = 0; e < 8; ++e) { const float el = (p0[4 + 8 * gi + e] + p1[4 + 8 * gi + e]) * rstd + AR.in[26][(layer * 4 + gi) * 8 + e];
                if (el > v0) { v1 = v0; i1 = i0; v0 = el; i0 = e; } else if (el > v1) { v1 = el; i1 = e; } }
            const float w1 = 1.0f / (1.0f + expf(v0 - v1)), w0 = 1.0f - w1;
            e0 = 8 * gi + i0; e1 = 8 * gi + i1; g0 = w0 * pg; g1 = w1 * pg;
            rk0 = atomicAdd((int*)&hist[e0], 1); rk1 = atomicAdd((int*)&hist[e1], 1);
        }
        __syncthreads();
        if (F.tid < 32) { const int h = hist[F.tid]; base[F.tid] = h ? (int)atomicAdd(&gcnt[F.tid], (unsigned)h) : 0; }
        __syncthreads();
        if (F.tid < 64) { const int t = 64 * u + F.tid; const int p0 = base[e0] + rk0, p1 = base[e1] + rk1;
            ltok[e0 * SEQ + p0] = t; lgate[e0 * SEQ + p0] = g0; lrs[e0 * SEQ + p0] = rstd; tslot[2 * t] = e0 * SEQ + p0;
            ltok[e1 * SEQ + p1] = t; lgate[e1 * SEQ + p1] = g1; lrs[e1 * SEQ + p1] = rstd; tslot[2 * t + 1] = e1 * SEQ + p1; }
    }
}
__device__ __forceinline__ void moe_table(const Frame& F, int layer) {
    LAS int* tab = (LAS int*)(F.lds + TAB_OFF);
    const unsigned* gcnt = (const unsigned*)(F.ws + WS_CTL) + CW_CNT + 32 * layer;
    __syncthreads();
    if (F.tid < 32) tab[F.tid] = (int)__hip_atomic_load((unsigned*)gcnt + F.tid, __ATOMIC_RELAXED, __HIP_MEMORY_SCOPE_AGENT);
    __syncthreads();
    if (F.tid == 0) { int s = 0; for (int e = 0; e < 32; ++e) { tab[32 + e] = s; s += (tab[e] + 255) >> 8; } }
    __syncthreads();
}
__device__ __forceinline__ void combine_phase(const Frame& F, const Args& AR, int layer) {
    unsigned char* ws = F.ws;
    bf16_t* XS = (bf16_t*)(ws + WS_XS); const bf16_t* O = (const bf16_t*)(ws + WS_O); const int* tslot = (const int*)(ws + WS_TOKSLOT);
    const LAS int* tab = (const LAS int*)(F.lds + TAB_OFF);
    const int gw = blockIdx.x * NWAVES + F.wave, NGW = F.G * NWAVES, lane = F.lane;
    for (int t = gw; t < SEQ; t += NGW) {
        const int s0 = tslot[2 * t], s1 = tslot[2 * t + 1];
        const size_t r0 = (size_t)(tab[32 + (s0 >> 14)] * 256 + (s0 & 16383)), r1 = (size_t)(tab[32 + (s1 >> 14)] * 256 + (s1 & 16383));
        const u32x4* xp = (const u32x4*)(XS + (size_t)t * DM) + lane; const u32x4* op0 = (const u32x4*)(O + r0 * DM) + lane; const u32x4* op1 = (const u32x4*)(O + r1 * DM) + lane;
        f32x4 v[4][2]; float ssq = 0.f;
#pragma unroll
        for (int j = 0; j < 4; ++j) { f32x4 a0, a1, b0, b1, c0, c1; unpack8(xp[64 * j], a0, a1); unpack8(op0[64 * j], b0, b1); unpack8(op1[64 * j], c0, c1);
            v[j][0] = a0 + (b0 + c0); v[j][1] = a1 + (b1 + c1); }
        if (layer == 0) {
#pragma unroll
            for (int j = 0; j < 4; ++j) { const u32x4 w = pack8(v[j][0], v[j][1]); ((u32x4*)(XS + (size_t)t * DM) + lane)[64 * j] = w; f32x4 a0, a1; unpack8(w, a0, a1);
                ssq += (a0.x * a0.x + a0.y * a0.y) + (a0.z * a0.z + a0.w * a0.w) + (a1.x * a1.x + a1.y * a1.y) + (a1.z * a1.z + a1.w * a1.w); }
            ssq = wave_sum(ssq);
            if (lane == 0) ((float*)(ws + WS_RSTD1))[t] = 1.0f / sqrtf(ssq * (1.0f / DM) + EPS);
        } else {
#pragma unroll
            for (int j = 0; j < 4; ++j) { const f32x4 a0 = v[j][0], a1 = v[j][1]; ssq += (a0.x * a0.x + a0.y * a0.y) + (a0.z * a0.z + a0.w * a0.w) + (a1.x * a1.x + a1.y * a1.y) + (a1.z * a1.z + a1.w * a1.w); }
            ssq = wave_sum(ssq); const float rs = 1.0f / sqrtf(ssq * (1.0f / DM) + EPS);
            float* orow = AR.out + (size_t)t * DM; const float* fg = AR.in[3];
#pragma unroll
            for (int j = 0; j < 4; ++j) { const int c = 8 * (lane + 64 * j); const f32x4 g0 = *(const f32x4*)(fg + c), g1 = *(const f32x4*)(fg + c + 4);
                *(f32x4*)(orow + c) = v[j][0] * rs * g0; *(f32x4*)(orow + c + 4) = v[j][1] * rs * g1; }
        }
    }
}

struct Cx { float r, i; };
__device__ __forceinline__ Cx cmul(Cx a, Cx b) { return Cx{a.r * b.r - a.i * b.i, a.r * b.i + a.i * b.r}; }
__device__ __forceinline__ Cx cfma(Cx a, Cx x, Cx b) { return Cx{a.r * x.r - a.i * x.i + b.r, a.r * x.i + a.i * x.r + b.i}; }
template <bool PASS2>
__device__ __forceinline__ void s5_phase(const Frame& F, const Args& AR) {
    unsigned char* ws = F.ws;
    const bf16_t* U = (const bf16_t*)(ws + WS_U); bf16_t* Z = (bf16_t*)(ws + WS_Z); float* EE = (float*)(ws + WS_EEND);
    const int lane = F.lane, q = lane & 31, hf = lane >> 5;
    LAS unsigned char* xs = F.lds + F.wave * (32 * 272);
    for (int u = blockIdx.x; u < 256; u += F.G) {
        const int g = u & 63, run = (u >> 6) * 8 + F.wave, t0 = run * 512;
        Cx A1[2], A2[2], A3[2], A4[2], A512[2]; bf16x8 Bf[4];
        const float dt = expf(AR.in[16][g]);
#pragma unroll
        for (int s = 0; s < 2; ++s) { const int st = g * 64 + 32 * s + q; const float lre = fminf(AR.in[14][st], -1e-4f), lim = AR.in[15][st];
            const float mag = expf(lre * dt); float sn, cs; sincosf(lim * dt, &sn, &cs); const float abr = mag * cs, abi = mag * sn, den = lre * lre + lim * lim;
            const float kr = ((abr - 1.0f) * lre + abi * lim) / den, ki = (abi * lre - (abr - 1.0f) * lim) / den;
            A1[s] = Cx{abr, abi}; A2[s] = cmul(A1[s], A1[s]); A3[s] = cmul(A2[s], A1[s]); A4[s] = cmul(A2[s], A2[s]);
            Cx p = A4[s];
#pragma unroll
            for (int k = 0; k < 7; ++k) p = cmul(p, p);
            A512[s] = p;
            const float* br = AR.in[17] + (size_t)st * 16 + 8 * hf; const float* bi = AR.in[18] + (size_t)st * 16 + 8 * hf;
            float vr[8], vi[8];
#pragma unroll
            for (int j = 0; j < 8; ++j) { vr[j] = kr * br[j] - ki * bi[j]; vi[j] = kr * bi[j] + ki * br[j]; }
            u32x4 wr_, wi_; wr_.x = cvt_pk_bf16(vr[0], vr[1]); wr_.y = cvt_pk_bf16(vr[2], vr[3]); wr_.z = cvt_pk_bf16(vr[4], vr[5]); wr_.w = cvt_pk_bf16(vr[6], vr[7]);
            wi_.x = cvt_pk_bf16(vi[0], vi[1]); wi_.y = cvt_pk_bf16(vi[2], vi[3]); wi_.z = cvt_pk_bf16(vi[4], vi[5]); wi_.w = cvt_pk_bf16(vi[6], vi[7]);
            Bf[s] = __builtin_bit_cast(bf16x8, wr_); Bf[2 + s] = __builtin_bit_cast(bf16x8, wi_); }
        Cx X[2] = {Cx{0.f, 0.f}, Cx{0.f, 0.f}};
        bf16x8 Cf[4]; float dsk = 0.f;
        if (PASS2) {
            for (int qq = 0; qq < run; ++qq) { const float* e = EE + ((size_t)qq * 64 + g) * 128;
                const Cx ea = Cx{e[q], e[64 + q]}, eb = Cx{e[32 + q], e[96 + q]}; X[0] = cfma(A512[0], X[0], ea); X[1] = cfma(A512[1], X[1], eb); }
            const int fr = lane & 15, fq = lane >> 4;
#pragma unroll
            for (int ks = 0; ks < 4; ++ks) { float v[8];
#pragma unroll
                for (int j = 0; j < 8; ++j) { const int comp = 32 * ks + 8 * fq + j; v[j] = comp < 64 ? AR.in[19][((size_t)g * 16 + fr) * 64 + comp] : -AR.in[20][((size_t)g * 16 + fr) * 64 + (comp - 64)]; }
                u32x4 w; w.x = cvt_pk_bf16(v[0], v[1]); w.y = cvt_pk_bf16(v[2], v[3]); w.z = cvt_pk_bf16(v[4], v[5]); w.w = cvt_pk_bf16(v[6], v[7]); Cf[ks] = __builtin_bit_cast(bf16x8, w); }
            dsk = AR.in[21][g * 16 + fr];
        }
        for (int sl = 0; sl < 16; ++sl) {
            const int ts = t0 + 32 * sl;
            const u32x4 uv = *(const u32x4*)(U + (size_t)(ts + q) * DSSM + g * 16 + 8 * hf);
            const bf16x8 uf = __builtin_bit_cast(bf16x8, uv);
            f32x16 acc[4];
#pragma unroll
            for (int n = 0; n < 4; ++n) {
#pragma unroll
                for (int i = 0; i < 16; ++i) acc[n][i] = 0.f;
                acc[n] = __builtin_amdgcn_mfma_f32_32x32x16_bf16(uf, Bf[n], acc[n], 0, 0, 0); }
            Cx E[2][4];
#pragma unroll
            for (int s = 0; s < 2; ++s)
#pragma unroll
                for (int rq = 0; rq < 4; ++rq) { Cx x = Cx{acc[s][4 * rq], acc[2 + s][4 * rq]};
#pragma unroll
                    for (int k = 1; k < 4; ++k) { x = cfma(A1[s], x, Cx{acc[s][4 * rq + k], acc[2 + s][4 * rq + k]}); acc[s][4 * rq + k] = x.r; acc[2 + s][4 * rq + k] = x.i; }
                    E[s][rq] = x; }
            Cx Xin[2][4];
#pragma unroll
            for (int s = 0; s < 2; ++s)
#pragma unroll
                for (int rq = 0; rq < 4; ++rq) { const Cx Eo = Cx{__shfl_xor(E[s][rq].r, 32), __shfl_xor(E[s][rq].i, 32)};
                    const Cx E0 = hf ? Eo : E[s][rq], E1 = hf ? E[s][rq] : Eo;
                    const Cx X0 = X[s]; X[s] = cfma(A4[s], X[s], E0); Xin[s][rq] = hf ? X[s] : X0; X[s] = cfma(A4[s], X[s], E1); }
            if (PASS2) {
#pragma unroll
                for (int s = 0; s < 2; ++s)
#pragma unroll
                    for (int rq = 0; rq < 4; ++rq) {
#pragma unroll
                        for (int k = 0; k < 4; ++k) { const int i = 4 * rq + k; const Cx ap = k == 0 ? A1[s] : k == 1 ? A2[s] : k == 2 ? A3[s] : A4[s];
                            const Cx x = cfma(ap, Xin[s][rq], Cx{acc[s][i], acc[2 + s][i]});
                            const int row = (i & 3) + 8 * (i >> 2) + 4 * hf;
                            *(LAS bf16_t*)(xs + row * 272 + (32 * s + q) * 2) = f2bf(x.r); *(LAS bf16_t*)(xs + row * 272 + (64 + 32 * s + q) * 2) = f2bf(x.i); } }
                const int fr = lane & 15, fq = lane >> 4;
#pragma unroll
                for (int mtile = 0; mtile < 2; ++mtile) { f32x4 y = (f32x4){0.f, 0.f, 0.f, 0.f};
#pragma unroll
                    for (int ks = 0; ks < 4; ++ks) { const bf16x8 af = *(const LAS bf16x8*)(xs + (16 * mtile + fr) * 272 + (32 * ks + 8 * fq) * 2); y = __builtin_amdgcn_mfma_f32_16x16x32_bf16(af, Cf[ks], y, 0, 0, 0); }
#pragma unroll
                    for (int r = 0; r < 4; ++r) { const int t = ts + 16 * mtile + 4 * fq + r; const size_t o = (size_t)t * DSSM + g * 16 + fr;
                        const float yy = y[r] + dsk * bf2f(U[o]); Z[o] = f2bf(gelu_tanh(yy)); } }
            }
        }
        if (!PASS2 && hf == 0) { float* e = EE + ((size_t)run * 64 + g) * 128; e[q] = X[0].r; e[32 + q] = X[1].r; e[64 + q] = X[0].i; e[96 + q] = X[1].i; }
    }
}

__global__ void __launch_bounds__(NTHR, 2) fwd(Args args) {
    extern __shared__ __attribute__((aligned(16))) unsigned char lds_raw[];
    Frame F; F.lds = (LAS unsigned char*)lds_raw; F.tid = threadIdx.x; F.lane = F.tid & 63; F.wave = __builtin_amdgcn_readfirstlane(F.tid >> 6); F.G = gridDim.x; F.ws = args.ws;
    volatile LAS unsigned* MISC = (volatile LAS unsigned*)(F.lds + MISC_OFF);
    if (F.tid < 64) MISC[F.tid] = 0u;
    __syncthreads();
    unsigned char* ws = args.ws;
    const int lo = args.ph_lo, hi = args.ph_hi;
    XcdBarrier bar; bar.bar = (unsigned*)(ws + WS_CTL) + CW_BAR; bar.x = 0; bar.st = nullptr;
    if (hi - lo > 1) bar = xcd_barrier_post((unsigned*)(ws + WS_CTL) + CW_BAR, MISC + 8);
#ifndef PHMASK
#define PHMASK 0x1ffff
#endif
#define IN(k) (((PHMASK >> ((k) > 8 ? (k) : (k))) & 1) && lo <= (k) && (k) < hi)
#define SEAM(k) do { if (IN(k) && IN((k) + 1)) xcd_barrier(bar); } while (0)

    if (IN(0)) { p0_prologue(F, args); } SEAM(0);
    if (IN(1)) { pg8::DenseSched S; S.init(ws + WS_XS, ws + WS_WINA, SEQ, 5120, 2048, F.G, (int)blockIdx.x);
        EpiG1 E{(bf16_t*)(ws + WS_G), (bf16_t*)(ws + WS_R), (const float*)(ws + WS_RSTD0)}; pg8::gemm_phase(F.lds, S, E); } SEAM(1);
    if (IN(2)) { a1_phase(F, args); } SEAM(2);
    if (IN(3)) { a2_phase(F, args); } SEAM(3);
    if (IN(4)) { pg8::DenseSched S; S.init(ws + WS_R, ws + WS_WOUTA, SEQ, 2048, 2560, F.G, (int)blockIdx.x);
        EpiRes E{(bf16_t*)(ws + WS_XS)}; pg8::gemm_phase(F.lds, S, E); } SEAM(4);
#define MOE_PHASES(layer, pb) \
    if (IN(pb + 4)) { router_phase(F, args, layer); } SEAM(pb + 4); \
    if (IN(pb + 5)) { \
        moe_table(F, layer); \
        pg8::MoeSched<true> S; S.init(ws + WS_XS, (const bf16_t*)(ws + WS_W13) + (size_t)layer * 32 * 1024 * 2048, 2048, 4, (size_t)1024 * 2048 * 2, (const LAS int*)(F.lds + TAB_OFF), (const LAS int*)(F.lds + TOKL_OFF)); \
        { LAS int* tokL = (LAS int*)(F.lds + TOKL_OFF); const int* ltok = (const int*)(ws + WS_LTOK); Unit uu; \
          for (int i = 0; i < 16; ++i) { if (!S.next(i, uu)) break; if (F.tid < 256) tokL[i * 256 + F.tid] = F.tid < uu.rows ? ltok[uu.e * SEQ + uu.lrow0 + F.tid] : 0; } \
          VM_WAIT(); __syncthreads(); } \
        EpiE1 E{(bf16_t*)(ws + WS_H), (const float*)(ws + WS_LRS)}; pg8::gemm_phase(F.lds, S, E); \
    } SEAM(pb + 5); \
    if (IN(pb + 6)) { \
        moe_table(F, layer); \
        pg8::MoeSched<false> S; S.init(ws + WS_H, (const bf16_t*)(ws + WS_W2) + (size_t)layer * 32 * 2048 * 512, 512, 8, (size_t)2048 * 512 * 2, (const LAS int*)(F.lds + TAB_OFF), nullptr); \
        EpiE2 E{(bf16_t*)(ws + WS_O), (const float*)(ws + WS_LGATE)}; pg8::gemm_phase(F.lds, S, E); \
    } SEAM(pb + 6); \
    if (IN(pb + 7)) { moe_table(F, layer); combine_phase(F, args, layer); } SEAM(pb + 7);
    MOE_PHASES(0, 1)
    if (IN(9)) { pg8::DenseSched S; S.init(ws + WS_XS, ws + WS_WINB, SEQ, 1024, 2048, F.G, (int)blockIdx.x);
        EpiScale E{(bf16_t*)(ws + WS_U), DSSM, (const float*)(ws + WS_RSTD1)}; pg8::gemm_phase(F.lds, S, E); } SEAM(9);
    if (IN(10)) { s5_phase<false>(F, args); } SEAM(10);
    if (IN(11)) { s5_phase<true>(F, args); } SEAM(11);
    if (IN(12)) { pg8::DenseSched S; S.init(ws + WS_Z, ws + WS_WGLU, SEQ, 4096, 1024, F.G, (int)blockIdx.x);
        EpiGlu E{(bf16_t*)(ws + WS_XS)}; pg8::gemm_phase(F.lds, S, E); } SEAM(12);
    MOE_PHASES(1, 9)
#undef MOE_PHASES
#undef IN
#undef SEAM
}

extern "C" void kernel_launch(void* const* d_in, const int* in_sizes, int n_in, void* d_out, int out_size, void* d_ws, size_t ws_size, hipStream_t stream) {
    static int grid = 0;
    if (grid == 0) {
        if (n_in != 30 || in_sizes[0] != SEQ * DM || out_size != SEQ * DM || ws_size < WS_END) { fprintf(stderr, "kernel_launch: unexpected shapes (n_in %d, in0 %d, out %d, ws %zu < %zu); nothing launched\n", n_in, n_in > 0 ? in_sizes[0] : -1, out_size, ws_size, (size_t)WS_END); grid = -1; return; }
        int dev = 0, cus = 0, per_cu = 0;
        if (hipGetDevice(&dev) != hipSuccess || hipDeviceGetAttribute(&cus, hipDeviceAttributeMultiprocessorCount, dev) != hipSuccess) { grid = -1; return; }
        if (hipFuncSetAttribute((const void*)fwd, hipFuncAttributeMaxDynamicSharedMemorySize, LDS_BYTES) != hipSuccess) { fprintf(stderr, "kernel_launch: hipFuncSetAttribute failed\n"); grid = -1; return; }
        if (hipOccupancyMaxActiveBlocksPerMultiprocessor(&per_cu, (const void*)fwd, NTHR, LDS_BYTES) != hipSuccess || per_cu < 1) fprintf(stderr, "kernel_launch: occupancy query reports %d blocks per CU\n", per_cu);
        (void)hipGetLastError();
        grid = cus < 256 ? cus : 256;
    }
    if (grid < 0) return;
    (void)hipMemsetAsync((char*)d_ws + WS_CTL, 0, CTL_BYTES, stream);
    Args a{};
    for (int i = 0; i < 30; ++i) a.in[i] = (const float*)d_in[i];
    a.out = (float*)d_out; a.ws = (unsigned char*)d_ws;
    if (MK_N_LAUNCHES == 1) { a.ph_lo = 0; a.ph_hi = NPH; hipLaunchKernelGGL(fwd, dim3(grid), dim3(NTHR), LDS_BYTES, stream, a); }
    else for (int p = 0; p < NPH; ++p) { a.ph_lo = p; a.ph_hi = p + 1; hipLaunchKernelGGL(fwd, dim3(grid), dim3(NTHR), LDS_BYTES, stream, a); }
}
```

```cpp
#include <hip/hip_runtime.h>
#include <cstdio>
#include <cstdint>

#ifndef MK_N_LAUNCHES
#define MK_N_LAUNCHES 1
#endif

#define LAS __attribute__((address_space(3)))
#define GAS __attribute__((address_space(1)))
typedef unsigned short bf16_t;
typedef short bf16x8 __attribute__((ext_vector_type(8)));
typedef float f32x2 __attribute__((ext_vector_type(2)));
typedef float f32x4 __attribute__((ext_vector_type(4)));
typedef float f32x16 __attribute__((ext_vector_type(16)));
typedef unsigned u32x2 __attribute__((ext_vector_type(2)));
typedef unsigned u32x4 __attribute__((ext_vector_type(4)));

constexpr int SEQ = 16384, DM = 2048, DRNN = 2560, NHEAD = 16, HDIM = 160, DSSM = 1024, SGRP = 64, SST = 64;
constexpr int NEXP = 32, DEXP = 512;
constexpr float EPS = 1e-6f;
constexpr int NPH = 17;
constexpr int NWAVES = 8, NTHR = 512;

constexpr size_t MiB = 1u << 20;
constexpr size_t WS_CTL = 0, CTL_BYTES = 1 * MiB;
constexpr size_t WS_WR = 1 * MiB;
constexpr size_t WS_WG = 2 * MiB;
constexpr size_t WS_RSTD0 = 4 * MiB;
constexpr size_t WS_RSTD1 = 4 * MiB + 65536;
constexpr size_t WS_TOKSLOT = 4 * MiB + 131072;
constexpr size_t WS_PSUM = 5 * MiB;
constexpr size_t WS_ESUM = 5 * MiB + 1310720;
constexpr size_t WS_EEND = 8 * MiB;
constexpr size_t WS_LTOK = 10 * MiB, WS_LGATE = 12 * MiB, WS_LRS = 14 * MiB;
constexpr size_t WS_WINA = 16 * MiB, WS_WOUTA = 36 * MiB, WS_WINB = 46 * MiB, WS_WGLU = 50 * MiB, WS_W13 = 58 * MiB, WS_W2 = 314 * MiB;
constexpr size_t WS_XS = 442 * MiB, WS_G = 506 * MiB, WS_R = 586 * MiB, WS_HL = 666 * MiB, WS_CP = 746 * MiB, WS_END = 826 * MiB;
constexpr size_t WS_O = WS_G, WS_H = WS_HL, WS_U = WS_CP, WS_Z = WS_CP + 32 * MiB;
constexpr int CW_CNT = 64;
constexpr int CW_BAR = 4096;

constexpr int RING_BYTES = 131072;
constexpr int TOKL_OFF = RING_BYTES;
constexpr int TAB_OFF = TOKL_OFF + 16384;
constexpr int MISC_OFF = TAB_OFF + 512;
constexpr int LDS_BYTES = MISC_OFF + 256;

__device__ __forceinline__ unsigned cvt_pk_bf16(float lo, float hi) { unsigned r; asm volatile("v_cvt_pk_bf16_f32 %0, %1, %2" : "=v"(r) : "v"(lo), "v"(hi)); return r; }
__device__ __forceinline__ float bf_lo(unsigned w) { return __uint_as_float(w << 16); }
__device__ __forceinline__ float bf_hi(unsigned w) { return __uint_as_float(w & 0xffff0000u); }
__device__ __forceinline__ float bf2f(bf16_t b) { return __uint_as_float(((unsigned)b) << 16); }
__device__ __forceinline__ bf16_t f2bf(float f) { return (bf16_t)(cvt_pk_bf16(f, 0.f) & 0xffffu); }
__device__ __forceinline__ float fast_sigmoid(float z) { return __builtin_amdgcn_rcpf(1.0f + __builtin_amdgcn_exp2f(-1.44269504089f * z)); }
__device__ __forceinline__ float gelu_tanh(float x) { const float u = 1.5957691216f * (x + 0.044715f * x * x * x); return x * fast_sigmoid(u); }
__device__ __forceinline__ float wave_sum(float v) {
#pragma unroll
    for (int o = 1; o < 64; o <<= 1) v += __shfl_xor(v, o);
    return v;
}
#define LDS_WAIT() asm volatile("s_waitcnt lgkmcnt(0)" ::: "memory")
#define VM_WAIT() asm volatile("s_waitcnt vmcnt(0)" ::: "memory")

#define XB_TMO      128
#define XB_XCNT(j)  (256  + 64 * (j))
#define XB_XSUB(j)  (1280 + 64 * (j))
#define XB_XGEN(j)  (2304 + 64 * (j))
#define XB_TOP      3328
#define XB_TOPGEN   3392
#define XCD_BAR_WORDS 3456
#define XB_SPIN_CAP (1u << 18)
__device__ __forceinline__ unsigned xb_ld(unsigned* p)              { return __hip_atomic_load(p, __ATOMIC_RELAXED, __HIP_MEMORY_SCOPE_AGENT); }
__device__ __forceinline__ unsigned xb_add(unsigned* p, unsigned v) { return __hip_atomic_fetch_add(p, v, __ATOMIC_RELAXED, __HIP_MEMORY_SCOPE_AGENT); }
__device__ __forceinline__ unsigned xb_xcc_id() { return (unsigned)__builtin_amdgcn_s_getreg((3 << 11) | 20) & 0xFu; }
#define XB_SPIN(cond, bar) do { unsigned _sp = 0; while (cond) { __builtin_amdgcn_s_sleep(1); \
    if ((++_sp & 255u) == 0u) { if (xb_ld(&(bar)[XB_TMO])) break; if (_sp > XB_SPIN_CAP) { atomicAdd(&(bar)[XB_TMO], 1u); break; } } } } while (0)
struct XcdBarrier { unsigned* bar; unsigned x; volatile LAS unsigned* st; };
__device__ __forceinline__ XcdBarrier xcd_barrier_post(unsigned* bar, volatile LAS unsigned* st) {
    XcdBarrier b; b.bar = bar; b.x = xb_xcc_id(); b.st = st;
    if (threadIdx.x == 0) (void)xb_add(&bar[XB_XCNT(b.x)], 1u);
    return b;
}
__device__ __forceinline__ void xcd_barrier_complete(unsigned* bar, unsigned x, unsigned& nloc, unsigned& nx) {
    const unsigned G = gridDim.x * gridDim.y * gridDim.z;
    unsigned sum, cnt, mine, sp = 0u;
    for (;;) {
        sum = 0u; cnt = 0u; mine = 0u;
#pragma unroll
        for (unsigned j = 0; j < 16; ++j) { const unsigned c = xb_ld(&bar[XB_XCNT(j)]); sum += c; cnt += (c > 0u) ? 1u : 0u; mine = (j == x) ? c : mine; }
        if (sum == G) break;
        __builtin_amdgcn_s_sleep(1);
        if ((++sp & 255u) == 0u) { if (xb_ld(&bar[XB_TMO])) break; if (sp > XB_SPIN_CAP) { atomicAdd(&bar[XB_TMO], 1u); break; } }
    }
    nloc = mine > 0u ? mine : 1u; nx = cnt > 0u ? cnt : 1u;
}
__device__ __forceinline__ void xcd_barrier(const XcdBarrier& b) {
    asm volatile("s_waitcnt vmcnt(0)" ::: "memory");
    __syncthreads();
    if (threadIdx.x == 0) {
        unsigned* bar = b.bar;
        __builtin_amdgcn_s_waitcnt(0);
        unsigned nloc = b.st[0], nx = b.st[1];
        if (nloc == 0u) { xcd_barrier_complete(bar, b.x, nloc, nx); b.st[0] = nloc; b.st[1] = nx; }
        const unsigned old = xb_add(&bar[XB_XSUB(b.x)], 1u);
        const unsigned gen = old / nloc;
        if (old + 1u == (gen + 1u) * nloc) {
            __builtin_amdgcn_fence(__ATOMIC_RELEASE, "agent");
            asm volatile("s_waitcnt vmcnt(0)" ::: "memory");
            const unsigned og = xb_add(&bar[XB_TOP], 1u);
            const unsigned tg = og / nx;
            if (og + 1u == (tg + 1u) * nx) xb_add(&bar[XB_TOPGEN], 1u);
            else XB_SPIN(xb_ld(&bar[XB_TOPGEN]) == tg, bar);
            __builtin_amdgcn_fence(__ATOMIC_ACQUIRE, "agent");
            xb_add(&bar[XB_XGEN(b.x)], 1u);
            asm volatile("s_waitcnt vmcnt(0)" ::: "memory");
        } else {
            XB_SPIN(xb_ld(&bar[XB_XGEN(b.x)]) == gen, bar);
            __builtin_amdgcn_fence(__ATOMIC_ACQUIRE, "agent");
            asm volatile("s_waitcnt vmcnt(0)" ::: "memory");
        }
    }
    __syncthreads();
}

namespace pg8 {
constexpr int BM = 256, BK = 64, HALF = 128, HTB = HALF * BK * 2, STAGE_BYTES = 8 * HTB, NXCD = 8, WGM = 8;
__host__ __device__ __forceinline__ int lds_byte(int r, int c) { const int st = (r >> 4) * 2 + (c >> 5), rr = r & 15, cc = c & 31, ob = rr * 64 + cc * 2; return st * 1024 + (ob ^ (((ob >> 9) & 1) << 5)); }
__host__ __device__ __forceinline__ void stage_rc(int b, int& R, int& C) { const int st = b / 1024, sb = b % 1024, swz = sb ^ (((sb >> 9) & 1) << 5); R = (st >> 1) * 16 + swz / 64; C = (st & 1) * 32 + (swz % 64) / 2; }
__host__ __device__ __forceinline__ int perm32(int rho) { const int n = rho >> 4, i = rho & 15; return 8 * (i >> 2) + 4 * n + (i & 3); }

struct Unit { int pm, pn, e, rows, hrow0, slot, lrow0; };

struct DenseSched {
    const char* A; const char* Bt; int K; int nM, nN, nwg, G, c;
    __device__ void init(const void* A_, const void* Bt_, int M, int N, int K_, int G_, int c_) { A = (const char*)A_; Bt = (const char*)Bt_; K = K_; nM = M / BM; nN = N / BM; nwg = nM * nN; G = G_; c = c_; }
    __device__ __forceinline__ bool next(int i, Unit& u) const {
        const long L = (long)i * G + c; if (L >= nwg) return false;
        int wgid = (int)L; { const int q = nwg / NXCD, r = nwg % NXCD, xcd = wgid % NXCD, off = wgid / NXCD; wgid = (xcd < r ? xcd * (q + 1) : r * (q + 1) + (xcd - r) * q) + off; }
        const int nig = WGM * nN, gid = wgid / nig, fm = gid * WGM, gsz = (nM - fm) < WGM ? (nM - fm) : WGM;
        u.pm = fm + ((wgid % nig) % gsz); u.pn = (wgid % nig) / gsz; u.e = 0; u.rows = 256; u.hrow0 = 0; u.slot = 0; u.lrow0 = 0; return true;
    }
    __device__ __forceinline__ int b_off(const Unit& u) const { return u.pn * BM * K * 2; }
    __device__ __forceinline__ void a_off(const Unit& u, unsigned (&off)[2][2]) const {
#pragma unroll
        for (int i = 0; i < 2; ++i) { int R, C; stage_rc((int)threadIdx.x * 16 + i * 8192, R, C);
#pragma unroll
            for (int h = 0; h < 2; ++h) off[h][i] = (unsigned)((u.pm * BM + h * HALF + R) * K + C) * 2u; }
    }
};
template <bool GATHER> struct MoeSched {
    const char* A; const char* Bt; int K; int NPN; size_t bstride; int x, rank, nrank; const LAS int* tab; const LAS int* tokL; int cum[5];
    __device__ void init(const void* A_, const void* Bt_, int K_, int NPN_, size_t bstride_, const LAS int* tab_, const LAS int* tokL_) {
        A = (const char*)A_; Bt = (const char*)Bt_; K = K_; NPN = NPN_; bstride = bstride_; tab = tab_; tokL = tokL_;
        const int G = gridDim.x, b = blockIdx.x; x = b & 7; rank = b >> 3; nrank = (G - x + 7) >> 3;
        cum[0] = 0;
#pragma unroll
        for (int j = 0; j < 4; ++j) { const int c = __builtin_amdgcn_readfirstlane(tab[x + 8 * j]); cum[j + 1] = cum[j] + ((c + 255) >> 8); }
    }
    __device__ __forceinline__ bool next(int i, Unit& u) const {
        const int L = i * nrank + rank; const int tl = L / NPN; if (tl >= cum[4]) return false;
        const int j = (tl >= cum[1]) + (tl >= cum[2]) + (tl >= cum[3]);
        const int cj = j == 0 ? cum[0] : j == 1 ? cum[1] : j == 2 ? cum[2] : cum[3];
        u.e = x + 8 * j; u.pm = tl - cj; u.pn = L - tl * NPN;
        const int c = __builtin_amdgcn_readfirstlane(tab[u.e]); const int rem = c - 256 * u.pm; u.rows = rem < 256 ? rem : 256; u.lrow0 = 256 * u.pm;
        u.hrow0 = (__builtin_amdgcn_readfirstlane(tab[32 + u.e]) + u.pm) * 256; u.slot = i; return true;
    }
    __device__ __forceinline__ int b_off(const Unit& u) const { return u.e * (int)bstride + u.pn * BM * K * 2; }
    __device__ __forceinline__ void a_off(const Unit& u, unsigned (&off)[2][2]) const {
#pragma unroll
        for (int i = 0; i < 2; ++i) { int R, C; stage_rc((int)threadIdx.x * 16 + i * 8192, R, C);
#pragma unroll
            for (int h = 0; h < 2; ++h) {
                if (GATHER) { const int tok = tokL[(u.slot & 15) * 256 + h * HALF + R]; off[h][i] = (unsigned)(tok * K + C) * 2u; }
                else off[h][i] = (unsigned)((u.hrow0 + h * HALF + R) * K + C) * 2u; } }
    }
};

template <class Epi, class Sched>
__device__ __forceinline__ void gemm_phase(LAS unsigned char* lds, const Sched& S, const Epi& E) {
    const int tid = threadIdx.x, wid = __builtin_amdgcn_readfirstlane(tid >> 6), lane = tid & 63, wr = wid >> 2, wc = wid & 3, fr = lane & 15, fq = lane >> 4;
    const int K = S.K, nt = K / BK;
    unsigned voffB[2];
#pragma unroll
    for (int i = 0; i < 2; ++i) { int R, C; stage_rc(tid * 16 + i * 8192, R, C); const int Rb = (R & ~31) + perm32(R & 31); voffB[i] = (unsigned)(Rb * K + C) * 2u; }
    const int kstep = BK * 2;
    const int hstep = HALF * K * 2;
    const unsigned ldsw = (unsigned)wid * 1024u;
    const int aoff = lds_byte(wr * 64 + fr, fq * 8), boff = lds_byte(wc * 32 + fr, fq * 8);
    const __amdgpu_buffer_rsrc_t rA = __builtin_amdgcn_make_buffer_rsrc((void*)S.A, 0, 0x7fffffff, 0x00020000);
    const __amdgpu_buffer_rsrc_t rB = __builtin_amdgcn_make_buffer_rsrc((void*)S.Bt, 0, 0x7fffffff, 0x00020000);
#define PG8_SA(b, h) (((b) * 2 + (h)) * HTB)
#define PG8_SB(b, h) ((4 + (b) * 2 + (h)) * HTB)
#define PG8_STAGE(bufoff, rsrc, voff, soff) do { _Pragma("unroll") for (int _i = 0; _i < 2; ++_i) \
        __builtin_amdgcn_raw_ptr_buffer_load_lds(rsrc, (LAS void*)(lds + (bufoff) + ldsw + _i * 8192), 16, (int)(voff)[_i], (int)(soff), 0, 0); } while (0)
#define PG8_LDA(dst, b, h) do { _Pragma("unroll") for (int m = 0; m < 4; ++m) _Pragma("unroll") for (int k = 0; k < 2; ++k) dst[m][k] = *(const LAS bf16x8*)(lds + PG8_SA(b, h) + aoff + m * 2048 + k * 1024); } while (0)
#define PG8_LDB(dst, b, h) do { _Pragma("unroll") for (int n = 0; n < 2; ++n) _Pragma("unroll") for (int k = 0; k < 2; ++k) dst[n][k] = *(const LAS bf16x8*)(lds + PG8_SB(b, h) + boff + n * 2048 + k * 1024); } while (0)
#define PG8_MMA(ai, bj, At, Bt) do { __builtin_amdgcn_s_setprio(1); _Pragma("unroll") for (int m = 0; m < 4; ++m) _Pragma("unroll") for (int n = 0; n < 2; ++n) _Pragma("unroll") for (int k = 0; k < 2; ++k) \
        acc[ai][bj][m][n] = __builtin_amdgcn_mfma_f32_16x16x32_bf16(Bt[n][k], At[m][k], acc[ai][bj][m][n], 0, 0, 0); __builtin_amdgcn_s_setprio(0); } while (0)
#define PG8_WAIT_V(n) asm volatile("s_waitcnt vmcnt(" #n ")" ::: "memory")
#define PG8_WAIT_L(n) asm volatile("s_waitcnt lgkmcnt(" #n ")" ::: "memory")
#define PG8_BAR __builtin_amdgcn_s_barrier()
#define PG8_SCHED __builtin_amdgcn_sched_barrier(0)
    Unit cur, nxt; int ui = 0;
    if (!S.next(0, cur)) return;
    f32x4 acc[2][2][4][2];
#pragma unroll
    for (int a = 0; a < 2; ++a)
#pragma unroll
        for (int b = 0; b < 2; ++b)
#pragma unroll
            for (int m = 0; m < 4; ++m)
#pragma unroll
                for (int n = 0; n < 2; ++n) acc[a][b][m][n] = (f32x4){0.f, 0.f, 0.f, 0.f};
    bf16x8 At[4][2], B0[2][2], B1[2][2];
    unsigned oC[2][2];
    S.a_off(cur, oC);
    int cB = S.b_off(cur);
    PG8_STAGE(PG8_SB(0, 0), rB, voffB, cB); PG8_STAGE(PG8_SB(0, 1), rB, voffB, cB + hstep); PG8_STAGE(PG8_SA(0, 0), rA, oC[0], 0); PG8_STAGE(PG8_SA(0, 1), rA, oC[1], 0);
    if (wr == 1) PG8_BAR;
    PG8_WAIT_V(2); PG8_BAR;
    PG8_STAGE(PG8_SB(1, 0), rB, voffB, cB + kstep); PG8_STAGE(PG8_SA(1, 0), rA, oC[0], kstep); PG8_STAGE(PG8_SB(1, 1), rB, voffB, cB + hstep + kstep);
    PG8_WAIT_V(6); PG8_BAR;
    for (;;) {
        const bool has_next = S.next(ui + 1, nxt);
        const int nB = has_next ? S.b_off(nxt) : cB;
        for (int t = 0; t < nt; t += 2) {
            const bool last = (t == nt - 2);
            const int a1 = (t + 1) * kstep;
            const int a2 = last ? 0 : (t + 2) * kstep, b2 = last ? nB : cB + (t + 2) * kstep;
            const int a3 = a2 + kstep, b3 = b2 + kstep;
            PG8_LDB(B0, 0, 0); PG8_LDB(B1, 0, 1); PG8_SCHED; PG8_LDA(At, 0, 0); PG8_STAGE(PG8_SA(1, 1), rA, oC[1], a1);
            if (last && has_next) S.a_off(nxt, oC);
            PG8_WAIT_V(8); PG8_WAIT_L(0); PG8_BAR; PG8_MMA(0, 0, At, B0); PG8_MMA(0, 1, At, B1); PG8_BAR; PG8_SCHED;
            PG8_LDA(At, 0, 1); PG8_STAGE(PG8_SB(0, 0), rB, voffB, b2); PG8_STAGE(PG8_SB(0, 1), rB, voffB, b2 + hstep); PG8_STAGE(PG8_SA(0, 0), rA, oC[0], a2);
            PG8_WAIT_V(8); PG8_WAIT_L(0); PG8_BAR; PG8_MMA(1, 0, At, B0); PG8_MMA(1, 1, At, B1); PG8_BAR; PG8_SCHED;
            PG8_LDB(B0, 1, 0); PG8_LDB(B1, 1, 1); PG8_SCHED; PG8_LDA(At, 1, 0); PG8_STAGE(PG8_SA(0, 1), rA, oC[1], a2);
            PG8_WAIT_V(8); PG8_WAIT_L(0); PG8_BAR; PG8_MMA(0, 0, At, B0); PG8_MMA(0, 1, At, B1); PG8_BAR; PG8_SCHED;
            PG8_LDA(At, 1, 1); PG8_STAGE(PG8_SB(1, 0), rB, voffB, b3); PG8_STAGE(PG8_SB(1, 1), rB, voffB, b3 + hstep); PG8_STAGE(PG8_SA(1, 0), rA, oC[0], a3);
            PG8_WAIT_V(8); PG8_WAIT_L(0); PG8_BAR; PG8_MMA(1, 0, At, B0); PG8_MMA(1, 1, At, B1); PG8_BAR; PG8_SCHED;
        }
        if (wr == 0) PG8_BAR;
        E(acc, cur, wr, wc, fr, fq);
        if (!has_next) break;
#pragma unroll
        for (int a = 0; a < 2; ++a)
#pragma unroll
            for (int b = 0; b < 2; ++b)
#pragma unroll
                for (int m = 0; m < 4; ++m)
#pragma unroll
                    for (int n = 0; n < 2; ++n) acc[a][b][m][n] = (f32x4){0.f, 0.f, 0.f, 0.f};
        cur = nxt; cB = nB; ++ui;
        if (wr == 1) PG8_BAR;
    }
    PG8_WAIT_V(0);
    PG8_BAR;
#undef PG8_SA
#undef PG8_SB
#undef PG8_STAGE
#undef PG8_LDA
#undef PG8_LDB
#undef PG8_MMA
#undef PG8_WAIT_V
#undef PG8_WAIT_L
#undef PG8_BAR
#undef PG8_SCHED
}
}
using pg8::Unit;

typedef const f32x4 (&AccRef)[2][2][4][2];
__device__ __forceinline__ u32x4 pack8(const f32x4 a, const f32x4 b) { u32x4 w; w.x = cvt_pk_bf16(a[0], a[1]); w.y = cvt_pk_bf16(a[2], a[3]); w.z = cvt_pk_bf16(b[0], b[1]); w.w = cvt_pk_bf16(b[2], b[3]); return w; }
__device__ __forceinline__ void unpack8(const u32x4 w, f32x4& a, f32x4& b) { a = (f32x4){bf_lo(w.x), bf_hi(w.x), bf_lo(w.y), bf_hi(w.y)}; b = (f32x4){bf_lo(w.z), bf_hi(w.z), bf_lo(w.w), bf_hi(w.w)}; }

struct EpiG1 {
    bf16_t* Gb; bf16_t* Rb; const float* rstd;
    __device__ __forceinline__ void operator()(AccRef acc, const Unit& u, int wr, int wc, int fr, int fq) const {
        const bool isg = u.pn < 10; bf16_t* base = isg ? Gb + u.pn * 256 : Rb + (u.pn - 10) * 256;
#pragma unroll
        for (int ai = 0; ai < 2; ++ai)
#pragma unroll
            for (int m = 0; m < 4; ++m) { const int row = u.pm * 256 + ai * 128 + wr * 64 + m * 16 + fr; const float s = rstd[row]; bf16_t* rowp = base + (size_t)row * DRNN + wc * 32 + 8 * fq;
#pragma unroll
                for (int bj = 0; bj < 2; ++bj) { f32x4 v0 = acc[ai][bj][m][0] * s, v1 = acc[ai][bj][m][1] * s;
                    if (isg) {
#pragma unroll
                        for (int j = 0; j < 4; ++j) { v0[j] = gelu_tanh(v0[j]); v1[j] = gelu_tanh(v1[j]); } }
                    *(u32x4*)(rowp + bj * 128) = pack8(v0, v1); } }
    }
};
struct EpiRes {
    bf16_t* XS;
    __device__ __forceinline__ void operator()(AccRef acc, const Unit& u, int wr, int wc, int fr, int fq) const {
#pragma unroll
        for (int ai = 0; ai < 2; ++ai)
#pragma unroll
            for (int m = 0; m < 4; ++m) { const int row = u.pm * 256 + ai * 128 + wr * 64 + m * 16 + fr; bf16_t* rowp = XS + (size_t)row * DM + u.pn * 256 + wc * 32 + 8 * fq;
#pragma unroll
                for (int bj = 0; bj < 2; ++bj) { const u32x4 old = *(const u32x4*)(rowp + bj * 128); f32x4 o0, o1; unpack8(old, o0, o1);
                    *(u32x4*)(rowp + bj * 128) = pack8(o0 + acc[ai][bj][m][0], o1 + acc[ai][bj][m][1]); } }
    }
};
struct EpiScale {
    bf16_t* U; int ldc; const float* rstd;
    __device__ __forceinline__ void operator()(AccRef acc, const Unit& u, int wr, int wc, int fr, int fq) const {
#pragma unroll
        for (int ai = 0; ai < 2; ++ai)
#pragma unroll
            for (int m = 0; m < 4; ++m) { const int row = u.pm * 256 + ai * 128 + wr * 64 + m * 16 + fr; const float s = rstd[row]; bf16_t* rowp = U + (size_t)row * ldc + u.pn * 256 + wc * 32 + 8 * fq;
#pragma unroll
                for (int bj = 0; bj < 2; ++bj) *(u32x4*)(rowp + bj * 128) = pack8(acc[ai][bj][m][0] * s, acc[ai][bj][m][1] * s); }
    }
};
struct EpiGlu {
    bf16_t* XS;
    __device__ __forceinline__ void operator()(AccRef acc, const Unit& u, int wr, int wc, int fr, int fq) const {
#pragma unroll
        for (int ai = 0; ai < 2; ++ai)
#pragma unroll
            for (int m = 0; m < 4; ++m) { const int row = u.pm * 256 + ai * 128 + wr * 64 + m * 16 + fr; bf16_t* rowp = XS + (size_t)row * DM + u.pn * 128 + wc * 32 + 8 * fq;
                const u32x4 old = *(const u32x4*)rowp; f32x4 o0, o1; unpack8(old, o0, o1);
#pragma unroll
                for (int j = 0; j < 4; ++j) { o0[j] += acc[ai][0][m][0][j] * fast_sigmoid(acc[ai][1][m][0][j]); o1[j] += acc[ai][0][m][1][j] * fast_sigmoid(acc[ai][1][m][1][j]); }
                *(u32x4*)rowp = pack8(o0, o1); }
    }
};
struct EpiE1 {
    bf16_t* H; const float* lrs;
    __device__ __forceinline__ void operator()(AccRef acc, const Unit& u, int wr, int wc, int fr, int fq) const {
#pragma unroll
        for (int ai = 0; ai < 2; ++ai)
#pragma unroll
            for (int m = 0; m < 4; ++m) { const int lr = ai * 128 + wr * 64 + m * 16 + fr;
                if (lr < u.rows) { const float s = lrs[u.e * SEQ + u.lrow0 + lr]; bf16_t* rowp = H + (size_t)(u.hrow0 + lr) * DEXP + u.pn * 128 + wc * 32 + 8 * fq;
                    f32x4 h0, h1;
#pragma unroll
                    for (int j = 0; j < 4; ++j) { const float a0 = acc[ai][0][m][0][j] * s, b0 = acc[ai][1][m][0][j] * s, a1 = acc[ai][0][m][1][j] * s, b1 = acc[ai][1][m][1][j] * s;
                        h0[j] = a0 * fast_sigmoid(a0) * b0; h1[j] = a1 * fast_sigmoid(a1) * b1; }
                    *(u32x4*)rowp = pack8(h0, h1); } }
    }
};
struct EpiE2 {
    bf16_t* O; const float* lgate;
    __device__ __forceinline__ void operator()(AccRef acc, const Unit& u, int wr, int wc, int fr, int fq) const {
#pragma unroll
        for (int ai = 0; ai < 2; ++ai)
#pragma unroll
            for (int m = 0; m < 4; ++m) { const int lr = ai * 128 + wr * 64 + m * 16 + fr;
                if (lr < u.rows) { const float s = lgate[u.e * SEQ + u.lrow0 + lr]; bf16_t* rowp = O + (size_t)(u.hrow0 + lr) * DM + u.pn * 256 + wc * 32 + 8 * fq;
#pragma unroll
                    for (int bj = 0; bj < 2; ++bj) *(u32x4*)(rowp + bj * 128) = pack8(acc[ai][bj][m][0] * s, acc[ai][bj][m][1] * s); } }
    }
};

struct Args { const float* in[30]; float* out; unsigned char* ws; int ph_lo, ph_hi; };
struct Frame { LAS unsigned char* lds; int tid, lane, wave, G; unsigned char* ws; };

struct TrItem { const float* W; const float* gain; bf16_t* WT; int ldw, k0, n0, K, drow0; };
__device__ __forceinline__ void tr_load(const TrItem& it, f32x4 (&v)[16], int lane) {
    const int lr = lane >> 4, lc = lane & 15; const float* p = it.W + (size_t)(it.k0 + lr) * it.ldw + it.n0 + 4 * lc;
#pragma unroll
    for (int i = 0; i < 16; ++i) v[i] = *(const f32x4*)(p + (size_t)(4 * i) * it.ldw);
}
__device__ __forceinline__ void tr_finish(const TrItem& it, const f32x4 (&v)[16], LAS float* scr, int lane) {
    const int lr = lane >> 4, lc = lane & 15;
#pragma unroll
    for (int i = 0; i < 16; ++i) { const int k = 4 * i + lr; *(LAS f32x4*)(scr + k * 64 + ((4 * lc) ^ (4 * ((k >> 3) & 7)))) = v[i]; }
    const int c = lane & 7, nn = lane >> 3;
    f32x4 g0 = (f32x4){1.f, 1.f, 1.f, 1.f}, g1 = g0;
    if (it.gain) { g0 = *(const f32x4*)(it.gain + it.k0 + 8 * c); g1 = *(const f32x4*)(it.gain + it.k0 + 8 * c + 4); }
    LDS_WAIT();
#pragma unroll
    for (int j = 0; j < 8; ++j) { const int n = 8 * j + nn; const LAS float* s = scr + (8 * c) * 64 + (n ^ (4 * c));
        u32x4 o; o.x = cvt_pk_bf16(s[0] * g0.x, s[64] * g0.y); o.y = cvt_pk_bf16(s[128] * g0.z, s[192] * g0.w); o.z = cvt_pk_bf16(s[256] * g1.x, s[320] * g1.y); o.w = cvt_pk_bf16(s[384] * g1.z, s[448] * g1.w);
        *(u32x4*)(it.WT + (size_t)(it.drow0 + n) * it.K + it.k0 + 8 * c) = o; }
    LDS_WAIT();
}
constexpr int I_WINA = 32 * 80, I_WOUTA = 40 * 32, I_WINB = 32 * 16, I_WGLU = 16 * 64, I_W1 = 64 * 256, I_W3 = I_W1, I_W2 = 64 * 256;
constexpr int TR_NITEMS = I_WINA + I_WOUTA + I_WINB + I_WGLU + I_W1 + I_W3 + I_W2;
__device__ __forceinline__ void tr_decode(int r, const Args& AR, unsigned char* ws, TrItem& it) {
    if (r < I_WINA) { const int kb = r / 80, nb = r % 80; it = TrItem{AR.in[4], AR.in[1], (bf16_t*)(ws + WS_WINA), 5120, 64 * kb, 64 * nb, 2048, 64 * nb}; return; } r -= I_WINA;
    if (r < I_WOUTA) { const int kb = r / 32, nb = r % 32; it = TrItem{AR.in[12], nullptr, (bf16_t*)(ws + WS_WOUTA), 2048, 64 * kb, 64 * nb, 2560, 64 * nb}; return; } r -= I_WOUTA;
    if (r < I_WINB) { const int kb = r / 16, nb = r % 16; it = TrItem{AR.in[13], AR.in[1] + 2048, (bf16_t*)(ws + WS_WINB), 1024, 64 * kb, 64 * nb, 2048, 64 * nb}; return; } r -= I_WINB;
    if (r < I_WGLU) { const int kb = r / 64, nb = r % 64; const int n0 = 64 * nb; const int nn = n0 & 2047; const int drow = 256 * (nn >> 7) + (nn & 127) + (n0 >= 2048 ? 128 : 0);
        it = TrItem{AR.in[22], nullptr, (bf16_t*)(ws + WS_WGLU), 4096, 64 * kb, n0, 1024, drow}; return; } r -= I_WGLU;
    if (r < I_W1 + I_W3) { const int which = r >= I_W1; if (which) r -= I_W1; const int mat = r >> 8, q = r & 255, kb = q >> 3, nb = q & 7, n0 = 64 * nb; const int l = mat >> 5;
        it = TrItem{(which ? AR.in[28] : AR.in[27]) + (size_t)mat * 2048 * 512, AR.in[2] + 2048 * l, (bf16_t*)(ws + WS_W13) + (size_t)mat * 1024 * 2048, 512, 64 * kb, n0, 2048, 256 * (n0 >> 7) + (n0 & 127) + 128 * which}; return; } r -= I_W1 + I_W3;
    { const int mat = r >> 8, q = r & 255, kb = q >> 5, nb = q & 31;
        it = TrItem{AR.in[29] + (size_t)mat * 512 * 2048, nullptr, (bf16_t*)(ws + WS_W2) + (size_t)mat * 2048 * 512, 2048, 64 * kb, 64 * nb, 512, 64 * nb}; }
}
__device__ __forceinline__ void p0_prologue(const Frame& F, const Args& AR) {
    unsigned char* ws = F.ws;
    LAS float* scr = (LAS float*)(F.lds + F.wave * 16384);
    const int gw = blockIdx.x * NWAVES + F.wave, NGW = F.G * NWAVES;
    { f32x4 va[16], vb[16]; TrItem ia, ib; int it = gw;
      if (it < TR_NITEMS) { tr_decode(it, AR, ws, ia); tr_load(ia, va, F.lane); }
      while (it < TR_NITEMS) {
          const int itb = it + NGW; if (itb < TR_NITEMS) { tr_decode(itb, AR, ws, ib); tr_load(ib, vb, F.lane); }
          tr_finish(ia, va, scr, F.lane);
          if (itb >= TR_NITEMS) break;
          const int itc = itb + NGW; if (itc < TR_NITEMS) { tr_decode(itc, AR, ws, ia); tr_load(ia, va, F.lane); }
          tr_finish(ib, vb, scr, F.lane);
          it = itc; } }
    const int gt = blockIdx.x * NTHR + F.tid, NGT = F.G * NTHR;
    { bf16_t* WR = (bf16_t*)(ws + WS_WR);
      for (int i = gt; i < 2 * 48 * 2048; i += NGT) { const int l = i / (48 * 2048), j = (i / 2048) % 48, k = i % 2048; float v = 0.f;
          if (j < 4) v = AR.in[23][((size_t)l * 2048 + k) * 4 + j]; else if (j < 36) { const int g = (j - 4) >> 3, e = (j - 4) & 7; v = AR.in[25][(((size_t)l * 4 + g) * 2048 + k) * 8 + e]; }
          WR[i] = f2bf(v * AR.in[2][l * 2048 + k]); } }
    { bf16_t* WG = (bf16_t*)(ws + WS_WG);
      for (int i = gt; i < 16 * 320 * 160; i += NGT) { const int h = i / (320 * 160), n = (i / 160) % 320, k = i % 160;
          const float v = n < 160 ? AR.in[7][((size_t)h * 160 + k) * 160 + n] : AR.in[9][((size_t)h * 160 + k) * 160 + (n - 160)]; WG[i] = f2bf(v); } }
    for (int m = gw; m < SEQ; m += NGW) {
        const f32x4* xr = (const f32x4*)(AR.in[0] + (size_t)m * DM) + F.lane; f32x4 v[8]; float s = 0.f;
#pragma unroll
        for (int j = 0; j < 8; ++j) { v[j] = xr[64 * j]; s += (v[j].x * v[j].x + v[j].y * v[j].y) + (v[j].z * v[j].z + v[j].w * v[j].w); }
        s = wave_sum(s);
        u32x2* o = (u32x2*)((bf16_t*)(ws + WS_XS) + (size_t)m * DM) + F.lane;
#pragma unroll
        for (int j = 0; j < 8; ++j) { u32x2 w; w.x = cvt_pk_bf16(v[j].x, v[j].y); w.y = cvt_pk_bf16(v[j].z, v[j].w); o[64 * j] = w; }
        if (F.lane == 0) ((float*)(ws + WS_RSTD0))[m] = 1.0f / sqrtf(s * (1.0f / DM) + EPS);
    }
}

constexpr int A1_WPITCH = 336, A1_CW_OFF = 320 * A1_WPITCH, A1_CB_OFF = A1_CW_OFF + 4 * 160 * 4;
__device__ __forceinline__ void a1_phase(const Frame& F, const Args& AR) {
    unsigned char* ws = F.ws;
    const bf16_t* Rb = (const bf16_t*)(ws + WS_R); unsigned* HC = (unsigned*)(ws + WS_HL);
    float* PS = (float*)(ws + WS_PSUM); float* ES = (float*)(ws + WS_ESUM);
    const int lane = F.lane, q = lane & 31, hf = lane >> 5;
    for (int u = blockIdx.x; u < 256; u += F.G) {
        const int head = u & 15, rb = u >> 4;
        __syncthreads();
        { const u32x4* src = (const u32x4*)((const bf16_t*)(ws + WS_WG) + (size_t)head * 320 * 160);
          for (int i = F.tid; i < 320 * 20; i += NTHR) { const int n = i / 20, c = i % 20; *(LAS u32x4*)(F.lds + n * A1_WPITCH + c * 16) = src[i]; }
          for (int i = F.tid; i < 4 * 160; i += NTHR) ((LAS float*)(F.lds + A1_CW_OFF))[i] = AR.in[5][(i / 160) * DRNN + head * 160 + (i % 160)];
          for (int i = F.tid; i < 160; i += NTHR) ((LAS float*)(F.lds + A1_CB_OFF))[i] = AR.in[6][head * 160 + i]; }
        __syncthreads();
        const int run = rb * 8 + F.wave, t0 = run * 128;
        float ba[5], bx[5], cL[5], Hs[5], Cs[5];
#pragma unroll
        for (int ct = 0; ct < 5; ++ct) { const int ch = head * 160 + 32 * ct + q; ba[ct] = AR.in[8][ch]; bx[ct] = AR.in[10][ch]; cL[ct] = -8.0f * log1pf(expf(-AR.in[11][ch])); Hs[ct] = 0.f; Cs[ct] = 1.f; }
        bf16x8 id0, id1;
#pragma unroll
        for (int j = 0; j < 8; ++j) { id0[j] = (q == 8 * hf + j) ? (short)0x3F80 : (short)0; id1[j] = (q == 16 + 8 * hf + j) ? (short)0x3F80 : (short)0; }
        for (int sl = 0; sl < 4; ++sl) {
            const int ts = t0 + 32 * sl, tok = ts + q;
            bf16x8 Af[10];
#pragma unroll
            for (int kk = 0; kk < 10; ++kk) {
                const int c0 = 16 * kk + 8 * hf;
                f32x4 a0 = *(const LAS f32x4*)(F.lds + A1_CB_OFF + c0 * 4), a1 = *(const LAS f32x4*)(F.lds + A1_CB_OFF + c0 * 4 + 16);
#pragma unroll
                for (int tp = 0; tp < 4; ++tp) { const int row = tok - 3 + tp;
                    u32x4 rv = (u32x4){0u, 0u, 0u, 0u}; if (row >= 0) rv = *(const u32x4*)(Rb + (size_t)row * DRNN + head * 160 + c0);
                    const f32x4 w0 = *(const LAS f32x4*)(F.lds + A1_CW_OFF + (tp * 160 + c0) * 4), w1 = *(const LAS f32x4*)(F.lds + A1_CW_OFF + (tp * 160 + c0) * 4 + 16);
                    f32x4 r0, r1; unpack8(rv, r0, r1); a0 += r0 * w0; a1 += r1 * w1; }
                const u32x4 pk = pack8(a0, a1); Af[kk] = __builtin_bit_cast(bf16x8, pk);
            }
#pragma unroll
            for (int ct = 0; ct < 5; ++ct) {
                f32x16 ar, ai, ac;
#pragma unroll
                for (int i = 0; i < 16; ++i) { ar[i] = 0.f; ai[i] = 0.f; ac[i] = 0.f; }
#pragma unroll
                for (int kk = 0; kk < 10; ++kk) {
                    const bf16x8 bR = *(const LAS bf16x8*)(F.lds + (32 * ct + q) * A1_WPITCH + (16 * kk + 8 * hf) * 2);
                    const bf16x8 bI = *(const LAS bf16x8*)(F.lds + (160 + 32 * ct + q) * A1_WPITCH + (16 * kk + 8 * hf) * 2);
                    ar = __builtin_amdgcn_mfma_f32_32x32x16_bf16(Af[kk], bR, ar, 0, 0, 0);
                    ai = __builtin_amdgcn_mfma_f32_32x32x16_bf16(Af[kk], bI, ai, 0, 0, 0);
                }
                ac = __builtin_amdgcn_mfma_f32_32x32x16_bf16(Af[2 * ct], id0, ac, 0, 0, 0);
                ac = __builtin_amdgcn_mfma_f32_32x32x16_bf16(Af[2 * ct + 1], id1, ac, 0, 0, 0);
                float hl[16], cp[16], P[4], E[4];
#pragma unroll
                for (int rq = 0; rq < 4; ++rq) { float h = 0.f, c = 1.f;
#pragma unroll
                    for (int k = 0; k < 4; ++k) { const int i = 4 * rq + k;
                        const float r = fast_sigmoid(ar[i] + ba[ct]), ig = fast_sigmoid(ai[i] + bx[ct]);
                        const float a = __builtin_amdgcn_exp2f(1.44269504089f * cL[ct] * r);
                        const float bt = __builtin_amdgcn_sqrtf(fmaxf(1.0f - a * a, 0.f)) * ig * ac[i];
                        h = a * h + bt; c = c * a; hl[i] = h; cp[i] = c; }
                    P[rq] = c; E[rq] = h; }
                float Hc = Hs[ct], Cc = Cs[ct], Hin[4], Cin[4];
#pragma unroll
                for (int rq = 0; rq < 4; ++rq) { const float Po = __shfl_xor(P[rq], 32), Eo = __shfl_xor(E[rq], 32);
                    const float P0 = hf ? Po : P[rq], E0 = hf ? Eo : E[rq], P1 = hf ? P[rq] : Po, E1 = hf ? E[rq] : Eo;
                    const float H0 = Hc, C0 = Cc; Hc = P0 * Hc + E0; Cc = Cc * P0;
                    Hin[rq] = hf ? Hc : H0; Cin[rq] = hf ? Cc : C0;
                    Hc = P1 * Hc + E1; Cc = Cc * P1; }
                Hs[ct] = Hc; Cs[ct] = Cc;
#pragma unroll
                for (int i = 0; i < 16; ++i) { const int rq = i >> 2; const int t = ts + (i & 3) + 8 * rq + 4 * hf; const size_t o = (size_t)t * DRNN + head * 160 + 32 * ct + q;
                    HC[o] = cvt_pk_bf16(hl[i] + cp[i] * Hin[rq], cp[i] * Cin[rq]); }
            }
        }
        if (hf == 0) {
#pragma unroll
            for (int ct = 0; ct < 5; ++ct) { const int ch = head * 160 + 32 * ct + q; PS[(size_t)run * DRNN + ch] = Cs[ct]; ES[(size_t)run * DRNN + ch] = Hs[ct]; } }
    }
}
__device__ __forceinline__ void a2_phase(const Frame& F, const Args& AR) {
    unsigned char* ws = F.ws;
    const unsigned* HC = (const unsigned*)(ws + WS_HL); const bf16_t* Gb = (const bf16_t*)(ws + WS_G); bf16_t* Y = (bf16_t*)(ws + WS_R);
    const float* PS = (const float*)(ws + WS_PSUM); const float* ES = (const float*)(ws + WS_ESUM);
    LAS float* car = (LAS float*)F.lds;
    for (int u = blockIdx.x; u < 256; u += F.G) {
        const int run = u >> 1, hfc = u & 1, ch0 = 1280 * hfc;
        __syncthreads();
        if (F.tid < 320) { f32x4 c = (f32x4){0.f, 0.f, 0.f, 0.f}; const float* pp = PS + ch0 + 4 * F.tid; const float* ep = ES + ch0 + 4 * F.tid;
            for (int q0 = 0; q0 < run; q0 += 8) { f32x4 Pq[8], Eq[8];
#pragma unroll
                for (int j = 0; j < 8; ++j) { const int qq = (q0 + j < run) ? q0 + j : run - 1; Pq[j] = *(const f32x4*)(pp + (size_t)qq * DRNN); Eq[j] = *(const f32x4*)(ep + (size_t)qq * DRNN); }
#pragma unroll
                for (int j = 0; j < 8; ++j) if (q0 + j < run) c = Pq[j] * c + Eq[j]; }
            *(LAS f32x4*)(car + 4 * F.tid) = c; }
        __syncthreads();
        for (int i0 = F.tid; i0 < 128 * 160; i0 += 4 * NTHR) { u32x4 ha[4], hb[4], g4[4]; size_t o[4]; int vv[4];
#pragma unroll
            for (int j = 0; j < 4; ++j) { const int idx = i0 + j * NTHR; const int t = idx / 160; vv[j] = idx - t * 160; o[j] = (size_t)(run * 128 + t) * DRNN + ch0 + 8 * vv[j];
                ha[j] = *(const u32x4*)(HC + o[j]); hb[j] = *(const u32x4*)(HC + o[j] + 4); g4[j] = *(const u32x4*)(Gb + o[j]); }
#pragma unroll
            for (int j = 0; j < 4; ++j) { f32x4 g0, g1; unpack8(g4[j], g0, g1);
                const f32x4 k0 = *(const LAS f32x4*)(car + 8 * vv[j]), k1 = *(const LAS f32x4*)(car + 8 * vv[j] + 4);
                const f32x4 h0 = (f32x4){bf_lo(ha[j].x), bf_lo(ha[j].y), bf_lo(ha[j].z), bf_lo(ha[j].w)}, c0 = (f32x4){bf_hi(ha[j].x), bf_hi(ha[j].y), bf_hi(ha[j].z), bf_hi(ha[j].w)};
                const f32x4 h1 = (f32x4){bf_lo(hb[j].x), bf_lo(hb[j].y), bf_lo(hb[j].z), bf_lo(hb[j].w)}, c1 = (f32x4){bf_hi(hb[j].x), bf_hi(hb[j].y), bf_hi(hb[j].z), bf_hi(hb[j].w)};
                *(u32x4*)(Y + o[j]) = pack8((h0 + c0 * k0) * g0, (h1 + c1 * k1) * g1); } }
    }
}

__device__ __forceinline__ void router_phase(const Frame& F, const Args& AR, int layer) {
    unsigned char* ws = F.ws;
    const bf16_t* XS = (const bf16_t*)(ws + WS_XS); const bf16_t* WR = (const bf16_t*)(ws + WS_WR) + (size_t)layer * 48 * 2048;
    unsigned* gcnt = (unsigned*)(ws + WS_CTL) + CW_CNT + 32 * layer;
    int* ltok = (int*)(ws + WS_LTOK); float* lgate = (float*)(ws + WS_LGATE); float* lrs = (float*)(ws + WS_LRS); int* tslot = (int*)(ws + WS_TOKSLOT);
    LAS float* part = (LAS float*)F.lds;
    LAS float* ssqp = (LAS float*)(F.lds + 2 * 64 * 48 * 4);
    LAS int* hist = (LAS int*)(F.lds + 2 * 64 * 48 * 4 + 512);
    LAS int* base = hist + 32;
    const int lane = F.lane, mt = F.wave & 3, kh = F.wave >> 2, fr = lane & 15, fq = lane >> 4;
    for (int u = blockIdx.x; u < SEQ / 64; u += F.G) {
        __syncthreads();
        if (F.tid < 32) hist[F.tid] = 0;
        f32x4 acc[3]; acc[0] = acc[1] = acc[2] = (f32x4){0.f, 0.f, 0.f, 0.f}; float ssq = 0.f;
        const bf16_t* xrow = XS + (size_t)(64 * u + 16 * mt + fr) * DM + 1024 * kh + 8 * fq;
        const bf16_t* wrow = WR + (size_t)fr * DM + 1024 * kh + 8 * fq;
#pragma unroll 4
        for (int ks = 0; ks < 32; ++ks) {
            const u32x4 av = *(const u32x4*)(xrow + 32 * ks); f32x4 a0, a1; unpack8(av, a0, a1);
            ssq += (a0.x * a0.x + a0.y * a0.y) + (a0.z * a0.z + a0.w * a0.w) + (a1.x * a1.x + a1.y * a1.y) + (a1.z * a1.z + a1.w * a1.w);
            const bf16x8 af = __builtin_bit_cast(bf16x8, av);
#pragma unroll
            for (int n = 0; n < 3; ++n) { const bf16x8 bfg = *(const bf16x8*)(wrow + (size_t)n * 16 * DM + 32 * ks); acc[n] = __builtin_amdgcn_mfma_f32_16x16x32_bf16(af, bfg, acc[n], 0, 0, 0); }
        }
        ssq += __shfl_xor(ssq, 16); ssq += __shfl_xor(ssq, 32);
        if (fq == 0) ssqp[kh * 64 + 16 * mt + fr] = ssq;
#pragma unroll
        for (int n = 0; n < 3; ++n)
#pragma unroll
            for (int r = 0; r < 4; ++r) part[(kh * 64 + 16 * mt + 4 * fq + r) * 48 + 16 * n + fr] = acc[n][r];
        __syncthreads();
        int e0 = 0, e1 = 0, rk0 = 0, rk1 = 0; float g0 = 0.f, g1 = 0.f, rstd = 0.f;
        if (F.tid < 64) {
            const int t = F.tid; const LAS float* p0 = part + t * 48; const LAS float* p1 = part + (64 + t) * 48;
            rstd = 1.0f / sqrtf((ssqp[t] + ssqp[64 + t]) * (1.0f / DM) + EPS);
            float gl[4]; int gi = 0; float gm = -3.0e38f;
#pragma unroll
            for (int j = 0; j < 4; ++j) { gl[j] = (p0[j] + p1[j]) * rstd + AR.in[24][layer * 4 + j]; if (gl[j] > gm) { gm = gl[j]; gi = j; } }
            float gs = 0.f;
#pragma unroll
            for (int j = 0; j < 4; ++j) gs += expf(gl[j] - gm);
            const float pg = 1.0f / gs;
            float v0 = -3.0e38f, v1 = -3.0e38f; int i0 = 0, i1 = 0;
#pragma unroll
            for (int e = 0; e < 8; ++e) { const float el = (p0[4 + 8 * gi + e] + p1[4 + 8 * gi + e]) * rstd + AR.in[26][(layer * 4 + gi) * 8 + e];
                if (el > v0) { v1 = v0; i1 = i0; v0 = el; i0 = e; } else if (el > v1) { v1 = el; i1 = e; } }
            const float w1 = 1.0f / (1.0f + expf(v0 - v1)), w0 = 1.0f - w1;
            e0 = 8 * gi + i0; e1 = 8 * gi + i1; g0 = w0 * pg; g1 = w1 * pg;
            rk0 = atomicAdd((int*)&hist[e0], 1); rk1 = atomicAdd((int*)&hist[e1], 1);
        }
        __syncthreads();
        if (F.tid < 32) { const int h = hist[F.tid]; base[F.tid] = h ? (int)atomicAdd(&gcnt[F.tid], (unsigned)h) : 0; }
        __syncthreads();
        if (F.tid < 64) { const int t = 64 * u + F.tid; const int p0 = base[e0] + rk0, p1 = base[e1] + rk1;
            ltok[e0 * SEQ + p0] = t; lgate[e0 * SEQ + p0] = g0; lrs[e0 * SEQ + p0] = rstd; tslot[2 * t] = e0 * SEQ + p0;
            ltok[e1 * SEQ + p1] = t; lgate[e1 * SEQ + p1] = g1; lrs[e1 * SEQ + p1] = rstd; tslot[2 * t + 1] = e1 * SEQ + p1; }
    }
}
__device__ __forceinline__ void moe_table(const Frame& F, int layer) {
    LAS int* tab = (LAS int*)(F.lds + TAB_OFF);
    const unsigned* gcnt = (const unsigned*)(F.ws + WS_CTL) + CW_CNT + 32 * layer;
    __syncthreads();
    if (F.tid < 32) tab[F.tid] = (int)__hip_atomic_load((unsigned*)gcnt + F.tid, __ATOMIC_RELAXED, __HIP_MEMORY_SCOPE_AGENT);
    __syncthreads();
    if (F.tid == 0) { int s = 0; for (int e = 0; e < 32; ++e) { tab[32 + e] = s; s += (tab[e] + 255) >> 8; } }
    __syncthreads();
}
__device__ __forceinline__ void combine_phase(const Frame& F, const Args& AR, int layer) {
    unsigned char* ws = F.ws;
    bf16_t* XS = (bf16_t*)(ws + WS_XS); const bf16_t* O = (const bf16_t*)(ws + WS_O); const int* tslot = (const int*)(ws + WS_TOKSLOT);
    const LAS int* tab = (const LAS int*)(F.lds + TAB_OFF);
    const int gw = blockIdx.x * NWAVES + F.wave, NGW = F.G * NWAVES, lane = F.lane;
    for (int t = gw; t < SEQ; t += NGW) {
        const int s0 = tslot[2 * t], s1 = tslot[2 * t + 1];
        const size_t r0 = (size_t)(tab[32 + (s0 >> 14)] * 256 + (s0 & 16383)), r1 = (size_t)(tab[32 + (s1 >> 14)] * 256 + (s1 & 16383));
        const u32x4* xp = (const u32x4*)(XS + (size_t)t * DM) + lane; const u32x4* op0 = (const u32x4*)(O + r0 * DM) + lane; const u32x4* op1 = (const u32x4*)(O + r1 * DM) + lane;
        f32x4 v[4][2]; float ssq = 0.f;
#pragma unroll
        for (int j = 0; j < 4; ++j) { f32x4 a0, a1, b0, b1, c0, c1; unpack8(xp[64 * j], a0, a1); unpack8(op0[64 * j], b0, b1); unpack8(op1[64 * j], c0, c1);
            v[j][0] = a0 + (b0 + c0); v[j][1] = a1 + (b1 + c1); }
        if (layer == 0) {
#pragma unroll
            for (int j = 0; j < 4; ++j) { const u32x4 w = pack8(v[j][0], v[j][1]); ((u32x4*)(XS + (size_t)t * DM) + lane)[64 * j] = w; f32x4 a0, a1; unpack8(w, a0, a1);
                ssq += (a0.x * a0.x + a0.y * a0.y) + (a0.z * a0.z + a0.w * a0.w) + (a1.x * a1.x + a1.y * a1.y) + (a1.z * a1.z + a1.w * a1.w); }
            ssq = wave_sum(ssq);
            if (lane == 0) ((float*)(ws + WS_RSTD1))[t] = 1.0f / sqrtf(ssq * (1.0f / DM) + EPS);
        } else {
#pragma unroll
            for (int j = 0; j < 4; ++j) { const f32x4 a0 = v[j][0], a1 = v[j][1]; ssq += (a0.x * a0.x + a0.y * a0.y) + (a0.z * a0.z + a0.w * a0.w) + (a1.x * a1.x + a1.y * a1.y) + (a1.z * a1.z + a1.w * a1.w); }
            ssq = wave_sum(ssq); const float rs = 1.0f / sqrtf(ssq * (1.0f / DM) + EPS);
            float* orow = AR.out + (size_t)t * DM; const float* fg = AR.in[3];
#pragma unroll
            for (int j = 0; j < 4; ++j) { const int c = 8 * (lane + 64 * j); const f32x4 g0 = *(const f32x4*)(fg + c), g1 = *(const f32x4*)(fg + c + 4);
                *(f32x4*)(orow + c) = v[j][0] * rs * g0; *(f32x4*)(orow + c + 4) = v[j][1] * rs * g1; }
        }
    }
}

struct Cx { float r, i; };
__device__ __forceinline__ Cx cmul(Cx a, Cx b) { return Cx{a.r * b.r - a.i * b.i, a.r * b.i + a.i * b.r}; }
__device__ __forceinline__ Cx cfma(Cx a, Cx x, Cx b) { return Cx{a.r * x.r - a.i * x.i + b.r, a.r * x.i + a.i * x.r + b.i}; }
constexpr int S5_XP = 336;
constexpr int S5_WAVE_LDS = 32 * S5_XP + 1024;
template <bool PASS2>
__device__ __forceinline__ void s5_phase(const Frame& F, const Args& AR) {
    unsigned char* ws = F.ws;
    const bf16_t* U = (const bf16_t*)(ws + WS_U); bf16_t* Z = (bf16_t*)(ws + WS_Z); float* EE = (float*)(ws + WS_EEND);
    const int lane = F.lane, q = lane & 31, hf = lane >> 5;
    LAS unsigned char* xs = F.lds + F.wave * S5_WAVE_LDS;
    LAS unsigned char* zs = xs + 32 * S5_XP;
    for (int u = blockIdx.x; u < 256; u += F.G) {
        const int g = u & 63, run = (u >> 6) * 8 + F.wave, t0 = run * 512;
        Cx A1[2], A2[2], A3[2], A4[2], A512[2]; bf16x8 Bf[4];
        const float dt = expf(AR.in[16][g]);
#pragma unroll
        for (int s = 0; s < 2; ++s) { const int st = g * 64 + 32 * s + q; const float lre = fminf(AR.in[14][st], -1e-4f), lim = AR.in[15][st];
            const float mag = expf(lre * dt); float sn, cs; sincosf(lim * dt, &sn, &cs); const float abr = mag * cs, abi = mag * sn, den = lre * lre + lim * lim;
            const float kr = ((abr - 1.0f) * lre + abi * lim) / den, ki = (abi * lre - (abr - 1.0f) * lim) / den;
            A1[s] = Cx{abr, abi}; A2[s] = cmul(A1[s], A1[s]); A3[s] = cmul(A2[s], A1[s]); A4[s] = cmul(A2[s], A2[s]);
            Cx p = A4[s];
#pragma unroll
            for (int k = 0; k < 7; ++k) p = cmul(p, p);
            A512[s] = p;
            const float* br = AR.in[17] + (size_t)st * 16 + 8 * hf; const float* bi = AR.in[18] + (size_t)st * 16 + 8 * hf;
            float vr[8], vi[8];
#pragma unroll
            for (int j = 0; j < 8; ++j) { vr[j] = kr * br[j] - ki * bi[j]; vi[j] = kr * bi[j] + ki * br[j]; }
            u32x4 wr_, wi_; wr_.x = cvt_pk_bf16(vr[0], vr[1]); wr_.y = cvt_pk_bf16(vr[2], vr[3]); wr_.z = cvt_pk_bf16(vr[4], vr[5]); wr_.w = cvt_pk_bf16(vr[6], vr[7]);
            wi_.x = cvt_pk_bf16(vi[0], vi[1]); wi_.y = cvt_pk_bf16(vi[2], vi[3]); wi_.z = cvt_pk_bf16(vi[4], vi[5]); wi_.w = cvt_pk_bf16(vi[6], vi[7]);
            Bf[s] = __builtin_bit_cast(bf16x8, wr_); Bf[2 + s] = __builtin_bit_cast(bf16x8, wi_); }
        Cx X[2] = {Cx{0.f, 0.f}, Cx{0.f, 0.f}};
        bf16x8 Cf[5];
        if (PASS2) {
            for (int qq = 0; qq < run; ++qq) { const float* e = EE + ((size_t)qq * 64 + g) * 128;
                const Cx ea = Cx{e[q], e[64 + q]}, eb = Cx{e[32 + q], e[96 + q]}; X[0] = cfma(A512[0], X[0], ea); X[1] = cfma(A512[1], X[1], eb); }
            const int fr = lane & 15, fq = lane >> 4;
#pragma unroll
            for (int ks = 0; ks < 4; ++ks) { float v[8];
#pragma unroll
                for (int j = 0; j < 8; ++j) { const int comp = 32 * ks + 8 * fq + j; v[j] = comp < 64 ? AR.in[19][((size_t)g * 16 + fr) * 64 + comp] : -AR.in[20][((size_t)g * 16 + fr) * 64 + (comp - 64)]; }
                u32x4 w; w.x = cvt_pk_bf16(v[0], v[1]); w.y = cvt_pk_bf16(v[2], v[3]); w.z = cvt_pk_bf16(v[4], v[5]); w.w = cvt_pk_bf16(v[6], v[7]); Cf[ks] = __builtin_bit_cast(bf16x8, w); }
            { const float dsk = AR.in[21][g * 16 + fr]; float v[8];
#pragma unroll
              for (int j = 0; j < 8; ++j) v[j] = (8 * fq + j == fr) ? dsk : 0.f;
              u32x4 w; w.x = cvt_pk_bf16(v[0], v[1]); w.y = cvt_pk_bf16(v[2], v[3]); w.z = cvt_pk_bf16(v[4], v[5]); w.w = cvt_pk_bf16(v[6], v[7]); Cf[4] = __builtin_bit_cast(bf16x8, w); }
            *(LAS u32x4*)(xs + q * S5_XP + (144 + 8 * hf) * 2) = (u32x4){0u, 0u, 0u, 0u};
        }
        const bf16_t* up = U + (size_t)(t0 + q) * DSSM + g * 16 + 8 * hf;
        u32x4 uv = *(const u32x4*)up;
        for (int sl = 0; sl < 16; ++sl) {
            const int ts = t0 + 32 * sl;
            const u32x4 ucur = uv;
            if (sl < 15) uv = *(const u32x4*)(up + (size_t)(32 * (sl + 1)) * DSSM);
            const bf16x8 uf = __builtin_bit_cast(bf16x8, ucur);
            f32x16 acc[4];
#pragma unroll
            for (int n = 0; n < 4; ++n) {
#pragma unroll
                for (int i = 0; i < 16; ++i) acc[n][i] = 0.f;
                acc[n] = __builtin_amdgcn_mfma_f32_32x32x16_bf16(uf, Bf[n], acc[n], 0, 0, 0); }
            Cx E[2][4];
#pragma unroll
            for (int s = 0; s < 2; ++s)
#pragma unroll
                for (int rq = 0; rq < 4; ++rq) { Cx x = Cx{acc[s][4 * rq], acc[2 + s][4 * rq]};
#pragma unroll
                    for (int k = 1; k < 4; ++k) { x = cfma(A1[s], x, Cx{acc[s][4 * rq + k], acc[2 + s][4 * rq + k]}); acc[s][4 * rq + k] = x.r; acc[2 + s][4 * rq + k] = x.i; }
                    E[s][rq] = x; }
            Cx Xin[2][4];
#pragma unroll
            for (int s = 0; s < 2; ++s)
#pragma unroll
                for (int rq = 0; rq < 4; ++rq) { const Cx Eo = Cx{__shfl_xor(E[s][rq].r, 32), __shfl_xor(E[s][rq].i, 32)};
                    const Cx E0 = hf ? Eo : E[s][rq], E1 = hf ? E[s][rq] : Eo;
                    const Cx X0 = X[s]; X[s] = cfma(A4[s], X[s], E0); Xin[s][rq] = hf ? X[s] : X0; X[s] = cfma(A4[s], X[s], E1); }
            if (PASS2) {
                *(LAS u32x4*)(xs + q * S5_XP + (128 + 8 * hf) * 2) = ucur;
#pragma unroll
                for (int s = 0; s < 2; ++s)
#pragma unroll
                    for (int rq = 0; rq < 4; ++rq) {
#pragma unroll
                        for (int k = 0; k < 4; ++k) { const int i = 4 * rq + k; const Cx ap = k == 0 ? A1[s] : k == 1 ? A2[s] : k == 2 ? A3[s] : A4[s];
                            const Cx x = cfma(ap, Xin[s][rq], Cx{acc[s][i], acc[2 + s][i]});
                            const int row = (i & 3) + 8 * (i >> 2) + 4 * hf;
                            *(LAS bf16_t*)(xs + row * S5_XP + (32 * s + q) * 2) = f2bf(x.r); *(LAS bf16_t*)(xs + row * S5_XP + (64 + 32 * s + q) * 2) = f2bf(x.i); } }
                const int fr = lane & 15, fq = lane >> 4;
#pragma unroll
                for (int mtile = 0; mtile < 2; ++mtile) { f32x4 y = (f32x4){0.f, 0.f, 0.f, 0.f};
#pragma unroll
                    for (int ks = 0; ks < 5; ++ks) { const bf16x8 af = *(const LAS bf16x8*)(xs + (16 * mtile + fr) * S5_XP + (32 * ks + 8 * fq) * 2); y = __builtin_amdgcn_mfma_f32_16x16x32_bf16(af, Cf[ks], y, 0, 0, 0); }
#pragma unroll
                    for (int r = 0; r < 4; ++r) *(LAS bf16_t*)(zs + (16 * mtile + 4 * fq + r) * 32 + fr * 2) = f2bf(gelu_tanh(y[r])); }
                const u32x4 zv = *(const LAS u32x4*)(zs + (lane >> 1) * 32 + (lane & 1) * 16);
                *(u32x4*)(Z + (size_t)(ts + (lane >> 1)) * DSSM + g * 16 + 8 * (lane & 1)) = zv;
            }
        }
        if (!PASS2 && hf == 0) { float* e = EE + ((size_t)run * 64 + g) * 128; e[q] = X[0].r; e[32 + q] = X[1].r; e[64 + q] = X[0].i; e[96 + q] = X[1].i; }
    }
}

__global__ void __launch_bounds__(NTHR, 2) fwd(Args args) {
    extern __shared__ __attribute__((aligned(16))) unsigned char lds_raw[];
    Frame F; F.lds = (LAS unsigned char*)lds_raw; F.tid = threadIdx.x; F.lane = F.tid & 63; F.wave = __builtin_amdgcn_readfirstlane(F.tid >> 6); F.G = gridDim.x; F.ws = args.ws;
    volatile LAS unsigned* MISC = (volatile LAS unsigned*)(F.lds + MISC_OFF);
    if (F.tid < 64) MISC[F.tid] = 0u;
    __syncthreads();
    unsigned char* ws = args.ws;
    const int lo = args.ph_lo, hi = args.ph_hi;
    XcdBarrier bar; bar.bar = (unsigned*)(ws + WS_CTL) + CW_BAR; bar.x = 0; bar.st = nullptr;
    if (hi - lo > 1) bar = xcd_barrier_post((unsigned*)(ws + WS_CTL) + CW_BAR, MISC + 8);
#ifndef PHMASK
#define PHMASK 0x1ffff
#endif
#define IN(k) (((PHMASK >> ((k) > 8 ? (k) : (k))) & 1) && lo <= (k) && (k) < hi)
#ifndef DUPMASK
#define DUPMASK 0
#endif
#define REP(k) for (int rep_ = 0; rep_ < (((DUPMASK >> (k)) & 1) ? 2 : 1); ++rep_)
#define SEAM(k) do { if (IN(k) && IN((k) + 1)) xcd_barrier(bar); } while (0)

    if (IN(0)) REP(0) { p0_prologue(F, args); } SEAM(0);
    if (IN(1)) REP(1) { pg8::DenseSched S; S.init(ws + WS_XS, ws + WS_WINA, SEQ, 5120, 2048, F.G, (int)blockIdx.x);
        EpiG1 E{(bf16_t*)(ws + WS_G), (bf16_t*)(ws + WS_R), (const float*)(ws + WS_RSTD0)}; pg8::gemm_phase(F.lds, S, E); } SEAM(1);
    if (IN(2)) REP(2) { a1_phase(F, args); } SEAM(2);
    if (IN(3)) REP(3) { a2_phase(F, args); } SEAM(3);
    if (IN(4)) { pg8::DenseSched S; S.init(ws + WS_R, ws + WS_WOUTA, SEQ, 2048, 2560, F.G, (int)blockIdx.x);
        EpiRes E{(bf16_t*)(ws + WS_XS)}; pg8::gemm_phase(F.lds, S, E); } SEAM(4);
#define MOE_PHASES(layer, pb) \
    if (IN(pb + 4)) { router_phase(F, args, layer); } SEAM(pb + 4); \
    if (IN(pb + 5)) REP(pb + 5) { \
        moe_table(F, layer); \
        pg8::MoeSched<true> S; S.init(ws + WS_XS, (const bf16_t*)(ws + WS_W13) + (size_t)layer * 32 * 1024 * 2048, 2048, 4, (size_t)1024 * 2048 * 2, (const LAS int*)(F.lds + TAB_OFF), (const LAS int*)(F.lds + TOKL_OFF)); \
        { LAS int* tokL = (LAS int*)(F.lds + TOKL_OFF); const int* ltok = (const int*)(ws + WS_LTOK); Unit uu; \
          for (int i = 0; i < 16; ++i) { if (!S.next(i, uu)) break; if (F.tid < 256) tokL[i * 256 + F.tid] = F.tid < uu.rows ? ltok[uu.e * SEQ + uu.lrow0 + F.tid] : 0; } \
          VM_WAIT(); __syncthreads(); } \
        EpiE1 E{(bf16_t*)(ws + WS_H), (const float*)(ws + WS_LRS)}; pg8::gemm_phase(F.lds, S, E); \
    } SEAM(pb + 5); \
    if (IN(pb + 6)) REP(pb + 6) { \
        moe_table(F, layer); \
        pg8::MoeSched<false> S; S.init(ws + WS_H, (const bf16_t*)(ws + WS_W2) + (size_t)layer * 32 * 2048 * 512, 512, 8, (size_t)2048 * 512 * 2, (const LAS int*)(F.lds + TAB_OFF), nullptr); \
        EpiE2 E{(bf16_t*)(ws + WS_O), (const float*)(ws + WS_LGATE)}; pg8::gemm_phase(F.lds, S, E); \
    } SEAM(pb + 6); \
    if (IN(pb + 7)) { moe_table(F, layer); combine_phase(F, args, layer); } SEAM(pb + 7);
    MOE_PHASES(0, 1)
    if (IN(9)) REP(9) { pg8::DenseSched S; S.init(ws + WS_XS, ws + WS_WINB, SEQ, 1024, 2048, F.G, (int)blockIdx.x);
        EpiScale E{(bf16_t*)(ws + WS_U), DSSM, (const float*)(ws + WS_RSTD1)}; pg8::gemm_phase(F.lds, S, E); } SEAM(9);
    if (IN(10)) REP(10) { s5_phase<false>(F, args); } SEAM(10);
    if (IN(11)) REP(11) { s5_phase<true>(F, args); } SEAM(11);
    if (IN(12)) { pg8::DenseSched S; S.init(ws + WS_Z, ws + WS_WGLU, SEQ, 4096, 1024, F.G, (int)blockIdx.x);
        EpiGlu E{(bf16_t*)(ws + WS_XS)}; pg8::gemm_phase(F.lds, S, E); } SEAM(12);
    MOE_PHASES(1, 9)
#undef MOE_PHASES
#undef IN
#undef SEAM
}

extern "C" void kernel_launch(void* const* d_in, const int* in_sizes, int n_in, void* d_out, int out_size, void* d_ws, size_t ws_size, hipStream_t stream) {
    static int grid = 0;
    if (grid == 0) {
        if (n_in != 30 || in_sizes[0] != SEQ * DM || out_size != SEQ * DM || ws_size < WS_END) { fprintf(stderr, "kernel_launch: unexpected shapes (n_in %d, in0 %d, out %d, ws %zu < %zu); nothing launched\n", n_in, n_in > 0 ? in_sizes[0] : -1, out_size, ws_size, (size_t)WS_END); grid = -1; return; }
        int dev = 0, cus = 0, per_cu = 0;
        if (hipGetDevice(&dev) != hipSuccess || hipDeviceGetAttribute(&cus, hipDeviceAttributeMultiprocessorCount, dev) != hipSuccess) { grid = -1; return; }
        if (hipFuncSetAttribute((const void*)fwd, hipFuncAttributeMaxDynamicSharedMemorySize, LDS_BYTES) != hipSuccess) { fprintf(stderr, "kernel_launch: hipFuncSetAttribute failed\n"); grid = -1; return; }
        if (hipOccupancyMaxActiveBlocksPerMultiprocessor(&per_cu, (const void*)fwd, NTHR, LDS_BYTES) != hipSuccess || per_cu < 1) fprintf(stderr, "kernel_launch: occupancy query reports %d blocks per CU\n", per_cu);
        (void)hipGetLastError();
        grid = cus < 256 ? cus : 256;
    }
    if (grid < 0) return;
    (void)hipMemsetAsync((char*)d_ws + WS_CTL, 0, CTL_BYTES, stream);
    Args a{};
    for (int i = 0; i < 30; ++i) a.in[i] = (const float*)d_in[i];
    a.out = (float*)d_out; a.ws = (unsigned char*)d_ws;
    if (MK_N_LAUNCHES == 1) { a.ph_lo = 0; a.ph_hi = NPH; hipLaunchKernelGGL(fwd, dim3(grid), dim3(NTHR), LDS_BYTES, stream, a); }
    else for (int p = 0; p < NPH; ++p) { a.ph_lo = p; a.ph_hi = p + 1; hipLaunchKernelGGL(fwd, dim3(grid), dim3(NTHR), LDS_BYTES, stream, a); }
}
```
